# Optimizing an MI355X kernel written in HIP

```python
import math
import jax
import jax.numpy as jnp
from jax import lax
import numpy as np

D_MODEL = 4096
BATCH = 2
SEQ = 8192
DEPTH = 2

HEAD_DIM = 128
D_MIX = D_MODEL
GROUP_W = D_MIX // 4

A_HEADS = GROUP_W // HEAD_DIM
A_KV_HEADS = 2
IDX_HEADS = A_HEADS // 2
IDX_DIM = 128
DSA_TOPK = 256
DSA_Q_BLOCK = 128

GLA_HEADS = 4
GLA_DV = GROUP_W // GLA_HEADS
GLA_DK = GLA_DV // 2
GLA_GATE_RANK = 16
GLA_TAU = 16.0
GLA_CHUNK = 64

GDN_HEADS = GROUP_W // HEAD_DIM
GDN_DK = HEAD_DIM
GDN_DV = HEAD_DIM
CONV_K = 4
GDN_CHUNK = 64

MOBA_HEADS = GROUP_W // HEAD_DIM
MOBA_BLOCK = 256
MOBA_TOPK = 3
MOBA_Q_BLOCK = 32

D_FF = 4 * D_MODEL
ROPE_THETA = 10000.0
LN_EPS = 1e-5
NORM_EPS = 1e-6
DEEPNORM_ALPHA = (2 * DEPTH) ** 0.25
DEEPNORM_BETA = (8 * DEPTH) ** -0.25

IN_SPLITS = (
    ('a_q', A_HEADS * HEAD_DIM), ('a_k', A_KV_HEADS * HEAD_DIM), ('a_v', A_KV_HEADS * HEAD_DIM),
    ('a_iq', IDX_HEADS * IDX_DIM), ('a_ik', IDX_DIM), ('a_iw', IDX_HEADS),
    ('b_q', GLA_HEADS * GLA_DK), ('b_k', GLA_HEADS * GLA_DK), ('b_v', GLA_HEADS * GLA_DV),
    ('b_glr', GLA_GATE_RANK), ('b_r', GROUP_W),
    ('c_q', GDN_HEADS * GDN_DK), ('c_k', GDN_HEADS * GDN_DK), ('c_v', GDN_HEADS * GDN_DV),
    ('c_a', GDN_HEADS), ('c_b', GDN_HEADS), ('c_g', GROUP_W),
    ('d_q', MOBA_HEADS * HEAD_DIM), ('d_k', MOBA_HEADS * HEAD_DIM), ('d_v', MOBA_HEADS * HEAD_DIM),
)
D_IN = sum(w for _, w in IN_SPLITS)
VALUE_COLS = ('a_v', 'b_v', 'c_v', 'd_v')

kernel_name = 'hybrid_dsa_gla_gdn_moba_deepnorm'

f32 = jnp.float32


def _value_col_scale():
    return np.concatenate([np.full((w,), DEEPNORM_BETA if n in VALUE_COLS else 1.0, np.float32)
                           for n, w in IN_SPLITS])


def _split_projection(z):
    offs = np.cumsum([w for _, w in IN_SPLITS])[:-1].tolist()
    return dict(zip([n for n, _ in IN_SPLITS], jnp.split(z, offs, axis=-1)))


def _layer_norm(x, g, b):
    xf = x.astype(f32)
    mu = jnp.mean(xf, axis=-1, keepdims=True)
    var = jnp.mean(jnp.square(xf - mu), axis=-1, keepdims=True)
    return ((xf - mu) * lax.rsqrt(var + LN_EPS)).astype(x.dtype) * g + b


def _rms_norm(x, g):
    xf = x.astype(f32)
    y = xf * lax.rsqrt(jnp.mean(jnp.square(xf), axis=-1, keepdims=True) + NORM_EPS)
    return y.astype(g.dtype) * g


def _l2_norm(x):
    xf = x.astype(f32)
    return xf * lax.rsqrt(jnp.sum(jnp.square(xf), axis=-1, keepdims=True) + NORM_EPS)


def _rope_tables(T, dtype):
    inv = ROPE_THETA ** (-jnp.arange(0, HEAD_DIM, 2, dtype=f32) / HEAD_DIM)
    ang = jnp.arange(T, dtype=f32)[:, None] * inv[None, :]
    return jnp.cos(ang).astype(dtype), jnp.sin(ang).astype(dtype)


def _rope(x, cos, sin):
    half = x.shape[-1] // 2
    x1, x2 = x[..., :half], x[..., half:]
    c, s = cos[None, :, None, :], sin[None, :, None, :]
    return jnp.concatenate([x1 * c - x2 * s, x2 * c + x1 * s], axis=-1)


def _causal_conv(x, w):
    K, T = w.shape[0], x.shape[1]
    xp = jnp.pad(x, ((0, 0), (K - 1, 0), (0, 0)))
    return sum(xp[:, i:i + T] * w[i] for i in range(K))


def _dsa_attention(q, k, v, iq, ik, iw, cos, sin):
    B, T, HQ, dh = q.shape
    HKV = k.shape[2]
    G = HQ // HKV
    topk = min(DSA_TOPK, T // 4)
    q, k, iq = _rope(q, cos, sin), _rope(k, cos, sin), _rope(iq, cos, sin)
    ik = _rope(ik[:, :, None, :], cos, sin)[:, :, 0, :]
    iw = iw * (IDX_HEADS ** -0.5 * IDX_DIM ** -0.5)
    scale = dh ** -0.5
    key_pos = jnp.arange(T)
    b_idx = jnp.arange(B)[:, None, None]

    def block(i):
        s0 = i * DSA_Q_BLOCK
        qb = lax.dynamic_slice_in_dim(q, s0, DSA_Q_BLOCK, axis=1)
        iqb = lax.dynamic_slice_in_dim(iq, s0, DSA_Q_BLOCK, axis=1)
        iwb = lax.dynamic_slice_in_dim(iw, s0, DSA_Q_BLOCK, axis=1)
        q_pos = s0 + jnp.arange(DSA_Q_BLOCK)
        rel = jax.nn.relu(jnp.einsum('bqhd,bsd->bhqs', iqb, ik))
        score = jnp.einsum('bqh,bhqs->bqs', iwb, rel).astype(f32)
        causal = key_pos[None, :] <= q_pos[:, None]
        score = jnp.where(causal[None], score, -jnp.inf)
        _, idx = lax.top_k(score, topk)
        valid = idx <= q_pos[None, :, None]
        k_sel = k[b_idx, idx]
        v_sel = v[b_idx, idx]
        qg = qb.reshape(B, DSA_Q_BLOCK, HKV, G, dh)
        s = jnp.einsum('bqhgd,bqnhd->bqhgn', qg, k_sel).astype(f32) * scale
        s = jnp.where(valid[:, :, None, None, :], s, -jnp.inf)
        p = jax.nn.softmax(s, axis=-1).astype(v.dtype)
        o = jnp.einsum('bqhgn,bqnhd->bqhgd', p, v_sel)
        return o.reshape(B, DSA_Q_BLOCK, HQ * dh)

    out = lax.map(block, jnp.arange(T // DSA_Q_BLOCK))
    return out.transpose(1, 0, 2, 3).reshape(B, T, HQ * dh)


def _gla(q, k, v, log_a):
    B, T, H, dk = q.shape
    dv = v.shape[-1]
    C = GLA_CHUNK
    NC = T // C

    def chunks(a):
        return a.astype(f32).reshape(B, NC, C, H, a.shape[-1]).transpose(1, 0, 3, 2, 4)

    incl = jnp.tril(jnp.ones((C, C), bool))

    def step(S, inp):
        qc, kc, vc, lc = inp
        b = jnp.cumsum(lc, axis=2)
        diff = jnp.where(incl[:, :, None], b[:, :, :, None, :] - b[:, :, None, :, :], -jnp.inf)
        att = jnp.einsum('bhid,bhijd,bhjd->bhij', qc, jnp.exp(diff), kc)
        o = jnp.einsum('bhij,bhjv->bhiv', att, vc) + jnp.einsum('bhik,bhkv->bhiv', qc * jnp.exp(b), S)
        b_last = b[:, :, -1:, :]
        S = jnp.exp(b_last)[:, :, 0, :, None] * S + jnp.einsum('bhjk,bhjv->bhkv', kc * jnp.exp(b_last - b), vc)
        return S, o

    S0 = jnp.zeros((B, H, dk, dv), f32)
    _, o = lax.scan(step, S0, (chunks(q), chunks(k), chunks(v), chunks(log_a)))
    return o.transpose(1, 0, 3, 2, 4).reshape(B, T, H, dv)


def _gated_delta_rule(q, k, v, beta, g):
    B, T, H, dk = q.shape
    dv = v.shape[-1]
    C = GDN_CHUNK
    NC = T // C

    def c4(a):
        return a.astype(f32).reshape(B, NC, C, H, a.shape[-1]).transpose(1, 0, 3, 2, 4)

    def c3(a):
        return a.astype(f32).reshape(B, NC, C, H).transpose(1, 0, 3, 2)

    incl = jnp.tril(jnp.ones((C, C), bool))
    strict = jnp.tril(jnp.ones((C, C), bool), -1)
    eye = jnp.eye(C, dtype=f32)

    def step(S, inp):
        qc, kc, vc, bc, gc = inp
        gam = jnp.cumsum(gc, axis=-1)
        decay = jnp.exp(jnp.where(incl, gam[..., :, None] - gam[..., None, :], -jnp.inf))
        kk = jnp.einsum('bhid,bhjd->bhij', kc, kc)
        a = jnp.where(strict, bc[..., :, None] * decay * kk, 0.0)
        rhs = jnp.concatenate([bc[..., None] * vc, (bc * jnp.exp(gam))[..., None] * kc], axis=-1)
        sol = lax.linalg.triangular_solve(eye + a, rhs, left_side=True, lower=True, unit_diagonal=True)
        u, w = sol[..., :dv], sol[..., dv:]
        delta = u - jnp.einsum('bhik,bhkv->bhiv', w, S)
        qk = jnp.einsum('bhid,bhjd->bhij', qc, kc) * decay
        o = (jnp.einsum('bhik,bhkv->bhiv', qc * jnp.exp(gam)[..., None], S)
             + jnp.einsum('bhij,bhjv->bhiv', qk, delta))
        g_last = gam[..., -1:]
        S = (jnp.exp(g_last)[..., None] * S
             + jnp.einsum('bhjk,bhjv->bhkv', kc * jnp.exp(g_last - gam)[..., None], delta))
        return S, o

    S0 = jnp.zeros((B, H, dk, dv), f32)
    _, o = lax.scan(step, S0, (c4(q), c4(k), c4(v), c3(beta), c3(g)))
    return o.transpose(1, 0, 3, 2, 4).reshape(B, T, H, dv)


def _moba_attention(q, k, v, cos, sin):
    B, T, H, dh = q.shape
    q, k = _rope(q, cos, sin), _rope(k, cos, sin)
    n_blocks = -(-T // MOBA_BLOCK)
    Tp = n_blocks * MOBA_BLOCK
    pad = Tp - T

    def to_bhtd(a):
        return jnp.pad(a, ((0, 0), (0, pad), (0, 0), (0, 0))).transpose(0, 2, 1, 3)

    q, k, v = to_bhtd(q), to_bhtd(k), to_bhtd(v)
    kb = k.reshape(B, H, n_blocks, MOBA_BLOCK, dh)
    vb = v.reshape(B, H, n_blocks, MOBA_BLOCK, dh)
    k_mean = jnp.mean(kb, axis=3)
    n_sel = min(MOBA_TOPK, n_blocks - 1)
    scale = dh ** -0.5
    blk_ids = jnp.arange(n_blocks)
    in_blk = jnp.arange(MOBA_BLOCK)
    b_idx = jnp.arange(B)[:, None, None, None]
    h_idx = jnp.arange(H)[None, :, None, None]

    def qblock(i):
        s0 = i * MOBA_Q_BLOCK
        qb = lax.dynamic_slice_in_dim(q, s0, MOBA_Q_BLOCK, axis=2)
        q_pos = s0 + jnp.arange(MOBA_Q_BLOCK)
        own = s0 // MOBA_BLOCK
        k_own = lax.dynamic_index_in_dim(kb, own, axis=2, keepdims=False)
        v_own = lax.dynamic_index_in_dim(vb, own, axis=2, keepdims=False)
        s_own = jnp.einsum('bhqd,bhkd->bhqk', qb, k_own).astype(f32) * scale
        own_pos = own * MOBA_BLOCK + in_blk
        s_own = jnp.where(own_pos[None, :] <= q_pos[:, None], s_own, -jnp.inf)
        if n_sel == 0:
            p = jax.nn.softmax(s_own, axis=-1).astype(v.dtype)
            return jnp.einsum('bhqk,bhkd->bhqd', p, v_own)
        gate = jnp.einsum('bhqd,bhnd->bhqn', qb, k_mean).astype(f32)
        gate = jnp.where(blk_ids < own, gate, -jnp.inf)
        _, sel = lax.top_k(gate, n_sel)
        valid = sel < own
        k_sel = kb[b_idx, h_idx, sel]
        v_sel = vb[b_idx, h_idx, sel]
        s_past = jnp.einsum('bhqd,bhqnkd->bhqnk', qb, k_sel).astype(f32) * scale
        s_past = jnp.where(valid[..., None], s_past, -jnp.inf)
        s_past = s_past.reshape(B, H, MOBA_Q_BLOCK, n_sel * MOBA_BLOCK)
        p = jax.nn.softmax(jnp.concatenate([s_past, s_own], axis=-1), axis=-1).astype(v.dtype)
        p_past = p[..., :n_sel * MOBA_BLOCK].reshape(B, H, MOBA_Q_BLOCK, n_sel, MOBA_BLOCK)
        p_own = p[..., n_sel * MOBA_BLOCK:]
        return (jnp.einsum('bhqnk,bhqnkd->bhqd', p_past, v_sel)
                + jnp.einsum('bhqk,bhkd->bhqd', p_own, v_own))

    out = lax.map(qblock, jnp.arange(Tp // MOBA_Q_BLOCK))
    out = out.transpose(1, 0, 3, 2, 4).reshape(B, Tp, H * dh)
    return out[:, :T]


def _token_mixers(h, w_in, gla_gate_w2, gla_gate_b, gla_norm_g, gdn_conv_w, gdn_a_log,
                  gdn_dt_bias, gdn_norm_g, cos, sin):
    B, T, _ = h.shape
    p = _split_projection(h @ w_in)

    def heads(a, n):
        return a.reshape(B, T, n, -1)

    y_a = _dsa_attention(heads(p['a_q'], A_HEADS), heads(p['a_k'], A_KV_HEADS), heads(p['a_v'], A_KV_HEADS),
                         heads(p['a_iq'], IDX_HEADS), p['a_ik'], p['a_iw'], cos, sin)

    gate_logit = (p['b_glr'] @ gla_gate_w2 + gla_gate_b).astype(f32)
    log_a = jax.nn.log_sigmoid(gate_logit) / GLA_TAU
    o_b = _gla(heads(p['b_q'], GLA_HEADS) * GLA_DK ** -0.5, heads(p['b_k'], GLA_HEADS),
               heads(p['b_v'], GLA_HEADS), heads(log_a, GLA_HEADS))
    y_b = (_rms_norm(o_b, gla_norm_g) * jax.nn.silu(heads(p['b_r'], GLA_HEADS))).reshape(B, T, GROUP_W)

    qkv = jax.nn.silu(_causal_conv(jnp.concatenate([p['c_q'], p['c_k'], p['c_v']], axis=-1), gdn_conv_w))
    cq, ck, cv = jnp.split(qkv, 3, axis=-1)
    cq = _l2_norm(heads(cq, GDN_HEADS)) * GDN_DK ** -0.5
    ck = _l2_norm(heads(ck, GDN_HEADS))
    beta = jax.nn.sigmoid(p['c_b'].astype(f32))
    g = -jnp.exp(gdn_a_log.astype(f32)) * jax.nn.softplus(p['c_a'].astype(f32) + gdn_dt_bias.astype(f32))
    o_c = _gated_delta_rule(cq, ck, heads(cv, GDN_HEADS), beta, g)
    y_c = (_rms_norm(o_c, gdn_norm_g) * jax.nn.silu(heads(p['c_g'], GDN_HEADS))).reshape(B, T, GROUP_W)

    y_d = _moba_attention(heads(p['d_q'], MOBA_HEADS), heads(p['d_k'], MOBA_HEADS),
                          heads(p['d_v'], MOBA_HEADS), cos, sin)

    return jnp.concatenate([y_a.astype(h.dtype), y_b.astype(h.dtype), y_c.astype(h.dtype), y_d.astype(h.dtype)], axis=-1)


def setup_inputs(seed: int = 0) -> dict:
    key = jax.random.key(seed)
    ks = jax.random.split(key, 19)
    L = DEPTH

    def nrm(k, shape, scale):
        return jax.random.normal(k, shape, jnp.float32) * scale

    x = nrm(ks[0], (BATCH, SEQ, D_MODEL), 1.0)
    ln_in_g = 1.0 + nrm(ks[1], (D_MODEL,), 0.02)
    ln_in_b = nrm(ks[2], (D_MODEL,), 0.02)
    w_in = nrm(ks[3], (L, D_MODEL, D_IN), D_MODEL ** -0.5) * jnp.asarray(_value_col_scale())
    w_out = nrm(ks[4], (L, D_MIX, D_MODEL), D_MIX ** -0.5) * DEEPNORM_BETA
    ln1_g = 1.0 + nrm(ks[5], (L, D_MODEL), 0.02)
    ln1_b = nrm(ks[6], (L, D_MODEL), 0.02)
    gla_gate_w2 = nrm(ks[7], (L, GLA_GATE_RANK, GLA_HEADS * GLA_DK), GLA_GATE_RANK ** -0.5)
    gla_gate_b = nrm(ks[8], (L, GLA_HEADS * GLA_DK), 0.02)
    gla_norm_g = 1.0 + nrm(ks[9], (L, GLA_DV), 0.02)
    gdn_conv_w = nrm(ks[10], (L, CONV_K, 3 * GROUP_W), CONV_K ** -0.5)
    gdn_a_log = jnp.log(jax.random.uniform(ks[11], (L, GDN_HEADS), jnp.float32, 1.0, 16.0))
    dt = jnp.exp(jax.random.uniform(ks[12], (L, GDN_HEADS), jnp.float32, math.log(1e-3), math.log(1e-1)))
    gdn_dt_bias = dt + jnp.log(-jnp.expm1(-dt))
    gdn_norm_g = 1.0 + nrm(ks[13], (L, GDN_DV), 0.02)
    w_up = nrm(ks[14], (L, D_MODEL, D_FF), D_MODEL ** -0.5) * DEEPNORM_BETA
    w_down = nrm(ks[15], (L, D_FF, D_MODEL), D_FF ** -0.5) * DEEPNORM_BETA
    ln2_g = 1.0 + nrm(ks[16], (L, D_MODEL), 0.02)
    ln2_b = nrm(ks[17], (L, D_MODEL), 0.02)
    return {'x': x, 'ln_in_g': ln_in_g, 'ln_in_b': ln_in_b, 'w_in': w_in, 'w_out': w_out,
            'ln1_g': ln1_g, 'ln1_b': ln1_b, 'gla_gate_w2': gla_gate_w2, 'gla_gate_b': gla_gate_b,
            'gla_norm_g': gla_norm_g, 'gdn_conv_w': gdn_conv_w, 'gdn_a_log': gdn_a_log,
            'gdn_dt_bias': gdn_dt_bias, 'gdn_norm_g': gdn_norm_g, 'w_up': w_up, 'w_down': w_down,
            'ln2_g': ln2_g, 'ln2_b': ln2_b}


def reference(x, ln_in_g, ln_in_b, w_in, w_out, ln1_g, ln1_b, gla_gate_w2, gla_gate_b, gla_norm_g,
              gdn_conv_w, gdn_a_log, gdn_dt_bias, gdn_norm_g, w_up, w_down, ln2_g, ln2_b):
    T = x.shape[1]
    cos, sin = _rope_tables(T, x.dtype)
    h = _layer_norm(x, ln_in_g, ln_in_b)
    for l in range(DEPTH):
        mix = _token_mixers(h, w_in[l], gla_gate_w2[l], gla_gate_b[l], gla_norm_g[l], gdn_conv_w[l],
                            gdn_a_log[l], gdn_dt_bias[l], gdn_norm_g[l], cos, sin)
        h = _layer_norm(DEEPNORM_ALPHA * h + mix @ w_out[l], ln1_g[l], ln1_b[l])
        ff = jnp.square(jax.nn.relu(h @ w_up[l])) @ w_down[l]
        h = _layer_norm(DEEPNORM_ALPHA * h + ff, ln2_g[l], ln2_b[l])
    return h
```

```cpp
#include <hip/hip_runtime.h>
#include <cstdio>
#include <cstdint>
namespace pg8 {
#define PG8_LAS __attribute__((address_space(3)))
typedef unsigned short bf16_t;
typedef short bf16x8 __attribute__((ext_vector_type(8)));
typedef float f32x4 __attribute__((ext_vector_type(4)));
typedef unsigned u32x4 __attribute__((ext_vector_type(4)));
constexpr int BM = 256, BK = 64, HALF = 128, HTB = HALF * BK * 2  , STAGE_BYTES = 8 * HTB, NXCD = 8, WGM = 8;

__host__ __device__ __forceinline__ int lds_byte(int r, int c) { const int st = (r >> 4) * 2 + (c >> 5), rr = r & 15, cc = c & 31, ob = rr * 64 + cc * 2; return st * 1024 + (ob ^ (((ob >> 9) & 1) << 5)); }
__host__ __device__ __forceinline__ void stage_rc(int b, int& R, int& C) { const int st = b / 1024, sb = b % 1024, swz = sb ^ (((sb >> 9) & 1) << 5); R = (st >> 1) * 16 + swz / 64; C = (st & 1) * 32 + (swz % 64) / 2; }
__host__ __device__ __forceinline__ int perm32(int rho) { const int n = rho >> 4, i = rho & 15; return 8 * (i >> 2) + 4 * n + (i & 3); }

struct Unit { int pm, pn; };
struct Gemm { const bf16_t* A; const bf16_t* Bt; int M, N, K; };

struct StaticOrder {
    int nM, nN, nwg, G, c;
    __host__ __device__ void init(int M, int N, int G_, int c_) { nM = M / BM; nN = N / BM; nwg = nM * nN; G = G_; c = c_; }
    __host__ __device__ bool next(int i, Unit& u) const {
        const long L = (long)i * G + c; if (L >= nwg) return false;
        int wgid = (int)L; { const int q = nwg / NXCD, r = nwg % NXCD, xcd = wgid % NXCD, off = wgid / NXCD; wgid = (xcd < r ? xcd * (q + 1) : r * (q + 1) + (xcd - r) * q) + off; }
        const int nig = WGM * nN, gid = wgid / nig, fm = gid * WGM, gsz = (nM - fm) < WGM ? (nM - fm) : WGM;
        u.pm = fm + ((wgid % nig) % gsz); u.pn = (wgid % nig) / gsz; return true;
    }
    __device__ __forceinline__ void a_ready(const Unit&) const {}
    __device__ __forceinline__ void done(const Unit&) const {}
};
struct ColumnOrder {
    int c, nM, pn;
    __host__ __device__ bool next(int i, Unit& u) const { if (i > 0 || c >= nM) return false; u.pm = c; u.pn = pn; return true; }
    __device__ __forceinline__ void a_ready(const Unit&) const {}
    __device__ __forceinline__ void done(const Unit&) const {}
};
__device__ __forceinline__ unsigned cvt_pk_bf16(float lo, float hi) { unsigned r; asm volatile("v_cvt_pk_bf16_f32 %0, %1, %2" : "=v"(r) : "v"(lo), "v"(hi)); return r; }
struct EpiStoreBf16 {
    static constexpr bool PERM = true, AFTER_DRAIN = false;
    bf16_t* O; int ldc;
    __device__ __forceinline__ void operator()(const f32x4 (&acc)[2][2][4][2], const Unit& u, int wr, int wc, int fr, int fq) const {
        const int row0 = u.pm * BM + wr * 64 + fr; const int col0 = u.pn * BM + wc * 32 + 8 * fq;
#pragma unroll
        for (int ai = 0; ai < 2; ++ai)
#pragma unroll
            for (int m = 0; m < 4; ++m) { bf16_t* rowp = O + (size_t)(row0 + ai * HALF + m * 16) * ldc + col0;
#pragma unroll
                for (int bj = 0; bj < 2; ++bj) { const f32x4 v0 = acc[ai][bj][m][0], v1 = acc[ai][bj][m][1];
                    u32x4 w; w.x = cvt_pk_bf16(v0[0], v0[1]); w.y = cvt_pk_bf16(v0[2], v0[3]); w.z = cvt_pk_bf16(v1[0], v1[1]); w.w = cvt_pk_bf16(v1[2], v1[3]);
                    *(u32x4*)(rowp + bj * HALF) = w; } }
    }
};
struct EpiSqRelu {
    static constexpr bool PERM = true, AFTER_DRAIN = false;
    bf16_t* O; int ldc;
    __device__ __forceinline__ void operator()(const f32x4 (&acc)[2][2][4][2], const Unit& u, int wr, int wc, int fr, int fq) const {
        const int row0 = u.pm * BM + wr * 64 + fr; const int col0 = u.pn * BM + wc * 32 + 8 * fq;
#pragma unroll
        for (int ai = 0; ai < 2; ++ai)
#pragma unroll
            for (int m = 0; m < 4; ++m) { bf16_t* rowp = O + (size_t)(row0 + ai * HALF + m * 16) * ldc + col0;
#pragma unroll
                for (int bj = 0; bj < 2; ++bj) { f32x4 v0 = acc[ai][bj][m][0], v1 = acc[ai][bj][m][1];
#pragma unroll
                    for (int j = 0; j < 4; ++j) { const float a = fmaxf(v0[j], 0.f), b = fmaxf(v1[j], 0.f); v0[j] = a * a; v1[j] = b * b; }
                    u32x4 w; w.x = cvt_pk_bf16(v0[0], v0[1]); w.y = cvt_pk_bf16(v0[2], v0[3]); w.z = cvt_pk_bf16(v1[0], v1[1]); w.w = cvt_pk_bf16(v1[2], v1[3]);
                    *(u32x4*)(rowp + bj * HALF) = w; } }
    }
};
struct EpiResidual {
    static constexpr bool PERM = false, AFTER_DRAIN = false;
    const float* Cs; float* Cd; int ldc; float alpha; const float* st; const float* g; const float* b;
    __device__ __forceinline__ void operator()(const f32x4 (&acc)[2][2][4][2], const Unit& u, int wr, int wc, int fr, int fq) const {
        const int row0 = u.pm * BM + wr * 64 + fr, col0 = u.pn * BM + wc * 32 + 4 * fq;
        f32x4 g4[2][2], b4[2][2];
#pragma unroll
        for (int bj = 0; bj < 2; ++bj)
#pragma unroll
            for (int n = 0; n < 2; ++n) { g4[bj][n] = *(const f32x4*)(g + col0 + bj * HALF + n * 16); b4[bj][n] = *(const f32x4*)(b + col0 + bj * HALF + n * 16); }
#pragma unroll
        for (int ai = 0; ai < 2; ++ai)
#pragma unroll
            for (int m = 0; m < 4; ++m) { const int row = row0 + ai * HALF + m * 16; const size_t ro = (size_t)row * ldc + col0;
                const float mean = st[2 * row], rstd = st[2 * row + 1];
#pragma unroll
                for (int bj = 0; bj < 2; ++bj)
#pragma unroll
                    for (int n = 0; n < 2; ++n) { const f32x4 x = *(const f32x4*)(Cs + ro + bj * HALF + n * 16);
                        const f32x4 h = (x - mean) * rstd * g4[bj][n] + b4[bj][n];
                        *(f32x4*)(Cd + ro + bj * HALF + n * 16) = h * alpha + acc[ai][bj][m][n]; } }
    }
};
template <class Epi, class Sched, bool ALIGN_EPI = false, bool SP2 = false>
__device__ __forceinline__ void gemm_phase(PG8_LAS unsigned char* lds, const Gemm g, const Sched& S, const Epi& E) {
    const int tid = threadIdx.x, wid = __builtin_amdgcn_readfirstlane(tid >> 6), lane = tid & 63, wr = wid >> 2, wc = wid & 3, fr = lane & 15, fq = lane >> 4;
    const int K = g.K, nt = K / BK;
    unsigned voffA[2], voffB[2];
#pragma unroll
    for (int i = 0; i < 2; ++i) { int R, C; stage_rc(tid * 16 + i * 8192, R, C); const int Rb = Epi::PERM ? ((R & ~31) + perm32(R & 31)) : R;
        voffA[i] = (unsigned)(R * K + C) * 2u; voffB[i] = (unsigned)(Rb * K + C) * 2u; }
    const size_t kstep = (size_t)(BK * 2);
    const size_t hstep = (size_t)HALF * K * 2;
    const size_t tstep = 2 * hstep;
    const unsigned ldsw = (unsigned)wid * 1024u;
    const int aoff = lds_byte(wr * 64 + fr, fq * 8), boff = lds_byte(wc * 32 + fr, fq * 8);
#define PG8_SA(b, h) (((b) * 2 + (h)) * HTB)
#define PG8_SB(b, h) ((4 + (b) * 2 + (h)) * HTB)
#define PG8_STAGE(bufoff, gbase, voff) do { _Pragma("unroll") for (int _i = 0; _i < 2; ++_i) \
        __builtin_amdgcn_global_load_lds((const unsigned*)((const char*)(gbase) + (voff)[_i]), (PG8_LAS unsigned*)(lds + (bufoff) + ldsw + _i * 8192), 16, 0, 0); } while (0)
#define PG8_LDA(dst, b, h) do { _Pragma("unroll") for (int m = 0; m < 4; ++m) _Pragma("unroll") for (int k = 0; k < 2; ++k) dst[m][k] = *(const PG8_LAS bf16x8*)(lds + PG8_SA(b, h) + aoff + m * 2048 + k * 1024); } while (0)
#define PG8_LDB(dst, b, h) do { _Pragma("unroll") for (int n = 0; n < 2; ++n) _Pragma("unroll") for (int k = 0; k < 2; ++k) dst[n][k] = *(const PG8_LAS bf16x8*)(lds + PG8_SB(b, h) + boff + n * 2048 + k * 1024); } while (0)
#define PG8_MMA(ai, bj, At, Bt) do { __builtin_amdgcn_s_setprio(1); _Pragma("unroll") for (int m = 0; m < 4; ++m) _Pragma("unroll") for (int n = 0; n < 2; ++n) _Pragma("unroll") for (int k = 0; k < 2; ++k) \
        acc[ai][bj][m][n] = __builtin_amdgcn_mfma_f32_16x16x32_bf16(Bt[n][k], At[m][k], acc[ai][bj][m][n], 0, 0, 0); __builtin_amdgcn_s_setprio(0); } while (0)
#define PG8_WAIT_V(n) asm volatile("s_waitcnt vmcnt(" #n ")" ::: "memory")
#define PG8_WAIT_L(n) asm volatile("s_waitcnt lgkmcnt(" #n ")" ::: "memory")
#define PG8_BAR __builtin_amdgcn_s_barrier()
#define PG8_SCHED __builtin_amdgcn_sched_barrier(0)
    Unit cur, nxt; int ui = 0;
    if (!S.next(0, cur)) return;
    f32x4 acc[2][2][4][2];
#pragma unroll
    for (int a = 0; a < 2; ++a)
#pragma unroll
        for (int b = 0; b < 2; ++b)
#pragma unroll
            for (int m = 0; m < 4; ++m)
#pragma unroll
                for (int n = 0; n < 2; ++n) acc[a][b][m][n] = (f32x4){0.f, 0.f, 0.f, 0.f};
    bf16x8 At[4][2], B0[2][2], B1[2][2];
    const char* cA = (const char*)g.A + (size_t)cur.pm * tstep; const char* cB = (const char*)g.Bt + (size_t)cur.pn * tstep;
    S.a_ready(cur);
    if constexpr (SP2) {
        PG8_STAGE(PG8_SB(0, 0), cB, voffB); PG8_STAGE(PG8_SB(0, 1), cB + hstep, voffB); PG8_STAGE(PG8_SA(0, 0), cA, voffA); PG8_STAGE(PG8_SA(0, 1), cA + hstep, voffA);
        if (wr == 1) PG8_BAR;
        PG8_WAIT_V(2); PG8_BAR;
        PG8_STAGE(PG8_SB(1, 0), cB + kstep, voffB); PG8_STAGE(PG8_SA(1, 0), cA + kstep, voffA); PG8_STAGE(PG8_SB(1, 1), cB + hstep + kstep, voffB);
        PG8_WAIT_V(6); PG8_BAR;
    } else {
        PG8_STAGE(PG8_SB(0, 0), cB, voffB); PG8_STAGE(PG8_SA(0, 0), cA, voffA); PG8_STAGE(PG8_SB(0, 1), cB + hstep, voffB); PG8_STAGE(PG8_SA(0, 1), cA + hstep, voffA);
        if (wr == 1) PG8_BAR;
        PG8_WAIT_V(4); PG8_BAR;
        PG8_STAGE(PG8_SB(1, 0), cB + kstep, voffB); PG8_STAGE(PG8_SA(1, 0), cA + kstep, voffA); PG8_STAGE(PG8_SB(1, 1), cB + hstep + kstep, voffB);
        PG8_WAIT_V(6); PG8_BAR;
    }
    for (;;) {
        const bool has_next = S.next(ui + 1, nxt);
        const char* nA = has_next ? (const char*)g.A + (size_t)nxt.pm * tstep : cA; const char* nB = has_next ? (const char*)g.Bt + (size_t)nxt.pn * tstep : cB;
        for (int t = 0; t < nt; t += 2) {
            const bool last = (t == nt - 2);
            const char* a1 = cA + (size_t)(t + 1) * kstep;
            const char* a2 = last ? nA : cA + (size_t)(t + 2) * kstep; const char* b2 = last ? nB : cB + (size_t)(t + 2) * kstep;
            const char* a3 = a2 + kstep; const char* b3 = b2 + kstep;
            if (last && has_next) S.a_ready(nxt);
            if constexpr (SP2) {
            PG8_LDB(B0, 0, 0); PG8_LDB(B1, 0, 1); PG8_SCHED; PG8_LDA(At, 0, 0); PG8_STAGE(PG8_SA(1, 1), a1 + hstep, voffA);
            PG8_WAIT_V(8); PG8_WAIT_L(0); PG8_BAR; PG8_MMA(0, 0, At, B0); PG8_MMA(0, 1, At, B1); PG8_BAR; PG8_SCHED;
            PG8_LDA(At, 0, 1); PG8_STAGE(PG8_SB(0, 0), b2, voffB); PG8_STAGE(PG8_SB(0, 1), b2 + hstep, voffB); PG8_STAGE(PG8_SA(0, 0), a2, voffA);
            PG8_WAIT_V(8); PG8_WAIT_L(0); PG8_BAR; PG8_MMA(1, 0, At, B0); PG8_MMA(1, 1, At, B1); PG8_BAR; PG8_SCHED;
            PG8_LDB(B0, 1, 0); PG8_LDB(B1, 1, 1); PG8_SCHED; PG8_LDA(At, 1, 0); PG8_STAGE(PG8_SA(0, 1), a2 + hstep, voffA);
            PG8_WAIT_V(8); PG8_WAIT_L(0); PG8_BAR; PG8_MMA(0, 0, At, B0); PG8_MMA(0, 1, At, B1); PG8_BAR; PG8_SCHED;
            PG8_LDA(At, 1, 1); PG8_STAGE(PG8_SB(1, 0), b3, voffB); PG8_STAGE(PG8_SB(1, 1), b3 + hstep, voffB); PG8_STAGE(PG8_SA(1, 0), a3, voffA);
            PG8_WAIT_V(8); PG8_WAIT_L(0); PG8_BAR; PG8_MMA(1, 0, At, B0); PG8_MMA(1, 1, At, B1); PG8_BAR; PG8_SCHED;
            } else {
            PG8_LDB(B0, 0, 0); PG8_SCHED; PG8_LDA(At, 0, 0); PG8_STAGE(PG8_SA(1, 1), a1 + hstep, voffA);
            PG8_WAIT_L(8); PG8_BAR; PG8_WAIT_L(0); PG8_MMA(0, 0, At, B0); PG8_BAR; PG8_SCHED;
            PG8_LDB(B1, 0, 1); PG8_STAGE(PG8_SB(0, 0), b2, voffB);
            PG8_BAR; PG8_WAIT_L(0); PG8_MMA(0, 1, At, B1); PG8_BAR;
            PG8_LDA(At, 0, 1); PG8_STAGE(PG8_SA(0, 0), a2, voffA);
            PG8_BAR; PG8_WAIT_L(0); PG8_MMA(1, 0, At, B0); PG8_BAR; PG8_SCHED;
            PG8_STAGE(PG8_SB(0, 1), b2 + hstep, voffB);
            PG8_WAIT_V(6); PG8_BAR; PG8_MMA(1, 1, At, B1); PG8_BAR;
            PG8_LDB(B0, 1, 0); PG8_SCHED; PG8_LDA(At, 1, 0); PG8_STAGE(PG8_SA(0, 1), a2 + hstep, voffA);
            PG8_WAIT_L(8); PG8_BAR; PG8_WAIT_L(0); PG8_MMA(0, 0, At, B0); PG8_BAR; PG8_SCHED;
            PG8_LDB(B1, 1, 1); PG8_STAGE(PG8_SB(1, 0), b3, voffB);
            PG8_BAR; PG8_WAIT_L(0); PG8_MMA(0, 1, At, B1); PG8_BAR;
            PG8_LDA(At, 1, 1); PG8_STAGE(PG8_SA(1, 0), a3, voffA);
            PG8_BAR; PG8_WAIT_L(0); PG8_MMA(1, 0, At, B0); PG8_BAR; PG8_SCHED;
            PG8_STAGE(PG8_SB(1, 1), b3 + hstep, voffB);
            PG8_WAIT_V(6); PG8_BAR; PG8_MMA(1, 1, At, B1); PG8_BAR;
            }
        }
        if constexpr (ALIGN_EPI) { if (wr == 0) PG8_BAR; }
        if constexpr (!Epi::AFTER_DRAIN) { E(acc, cur, wr, wc, fr, fq); S.done(cur); }
        if (!has_next) break;
#pragma unroll
        for (int a = 0; a < 2; ++a)
#pragma unroll
            for (int b = 0; b < 2; ++b)
#pragma unroll
                for (int m = 0; m < 4; ++m)
#pragma unroll
                    for (int n = 0; n < 2; ++n) acc[a][b][m][n] = (f32x4){0.f, 0.f, 0.f, 0.f};
        cur = nxt; cA = nA; cB = nB; ++ui;
        if constexpr (ALIGN_EPI) { if (wr == 1) PG8_BAR; }
    }
    PG8_WAIT_V(0);
    if constexpr (!ALIGN_EPI) { if (wr == 0) PG8_BAR; }
    PG8_BAR;
    if constexpr (Epi::AFTER_DRAIN) { E.fused(acc, cur, wr, wc, fr, fq, lds, wid, lane); S.done(cur); }
#undef PG8_SA
#undef PG8_SB
#undef PG8_STAGE
#undef PG8_LDA
#undef PG8_LDB
#undef PG8_MMA
#undef PG8_WAIT_V
#undef PG8_WAIT_L
#undef PG8_BAR
#undef PG8_SCHED
}
}
constexpr int NB = 2, T = 8192, D = 4096, M = NB * T, DIN = 12452, LDZ = 12544, DFF = 16384, NLAYER = 2;
constexpr float LN_EPS = 1e-5f, NORM_EPS = 1e-6f;
constexpr float DN_ALPHA = 1.4142135623730951f;
constexpr int ZA_Q = 0, ZA_K = 1024, ZA_V = 1280, ZA_IQ = 1536, ZA_IK = 2048, ZB_Q = 2176, ZB_K = 2688, ZB_V = 3200, ZB_R = 4224,
              ZC_Q = 5248, ZC_K = 6272, ZC_V = 7296, ZC_G = 8320, ZD_Q = 9344, ZD_K = 10368, ZD_V = 11392,
              ZS_IW = 12416, ZS_GLR = 12420, ZS_CA = 12436, ZS_CB = 12444;
constexpr int MX_A = 0, MX_B = 1024, MX_C = 2048, MX_D = 3072;
constexpr size_t MiB = 1u << 20;
constexpr size_t WS_CTL = 0, CTL_ZERO_BYTES = 1 * MiB;
constexpr size_t WS_ROPE = 1 * MiB;
constexpr size_t WS_KMEAN = 5 * MiB;
constexpr size_t WS_IK = 9 * MiB;
constexpr size_t WS_GLA_DL = 6 * MiB;
constexpr size_t WS_GDN_DL = 7 * MiB;
constexpr size_t WS_STATS = 8 * MiB;
constexpr size_t WS_WIN = 16 * MiB, WIN_BYTES = (size_t)LDZ * D * 2;
constexpr size_t WS_WOUT = WS_WIN + 2 * WIN_BYTES, WOUT_BYTES = (size_t)D * D * 2;
constexpr size_t WS_WUP = WS_WOUT + 2 * WOUT_BYTES, WUP_BYTES = (size_t)DFF * D * 2;
constexpr size_t WS_WDN = WS_WUP + 2 * WUP_BYTES, WDN_BYTES = (size_t)D * DFF * 2;
constexpr size_t WS_HB = WS_WDN + 2 * WDN_BYTES;
constexpr size_t WS_Z = WS_HB + (size_t)M * D * 2;
constexpr size_t WS_MIX = WS_Z + (size_t)M * LDZ * 2;
constexpr size_t WS_FF = WS_Z;
constexpr size_t WS_SCR = WS_MIX + (size_t)M * D * 2;
static_assert(WS_FF + (size_t)M * DFF * 2 <= WS_SCR, "FF overlay");
constexpr size_t WS_GLA_HT = WS_SCR;
constexpr size_t WS_GLA_ST = WS_GLA_HT + (size_t)1024 * 256 * 128 * 4;
constexpr size_t WS_GDN_FR = WS_GLA_ST + (size_t)1024 * 256 * 128 * 2;
constexpr size_t WS_GDN_UT = WS_GDN_FR + (size_t)2048 * 57344;
constexpr size_t WS_GDN_O = WS_GDN_UT + (size_t)2048 * 128 * 64 * 4;
constexpr size_t WS_MASK = WS_GDN_O + (size_t)M * 1024 * 4;
constexpr size_t WS_VTA = WS_MASK + (size_t)M * 256 * 4;
constexpr size_t WS_VTD = WS_VTA + (size_t)2 * 2 * 128 * T * 2;
constexpr size_t WS_END = WS_VTD + (size_t)2 * 8 * 128 * T * 2;
static_assert(WS_END <= (size_t)2040 * MiB, "workspace budget");
constexpr int CW_BAR = 4096;
constexpr int CW_QUEUE = 8192;
constexpr int LDS_BYTES = 163840;
constexpr int MISC_OFF = LDS_BYTES - 256;
constexpr int NWAVES = 8, NTHREADS = 512;

#define GAS __attribute__((address_space(1)))
#define LAS __attribute__((address_space(3)))
typedef unsigned short bf16;
typedef unsigned v4u __attribute__((ext_vector_type(4)));
typedef unsigned v2u __attribute__((ext_vector_type(2)));
typedef float f32x4 __attribute__((ext_vector_type(4)));
typedef float f32x2 __attribute__((ext_vector_type(2)));
typedef float f32x16 __attribute__((ext_vector_type(16)));
typedef short bf16x8 __attribute__((ext_vector_type(8)));
typedef short bf16x4 __attribute__((ext_vector_type(4)));
typedef GAS unsigned gu32;
#define RLX_AGENT __ATOMIC_RELAXED, __HIP_MEMORY_SCOPE_AGENT
#define LDS_WAIT() asm volatile("s_waitcnt lgkmcnt(0)" ::: "memory")
#define VM_WAIT() asm volatile("s_waitcnt vmcnt(0)" ::: "memory")
__device__ __forceinline__ unsigned f2bf(float f) { unsigned u = __builtin_bit_cast(unsigned, f); return (u + 0x7fffu + ((u >> 16) & 1u)) >> 16; }
typedef __bf16 hbf16x2 __attribute__((ext_vector_type(2)));
__device__ __forceinline__ unsigned pk2(float lo, float hi) { const f32x2 v = {lo, hi}; return __builtin_bit_cast(unsigned, __builtin_convertvector(v, hbf16x2)); }
__device__ __forceinline__ float bf2f(unsigned h) { return __builtin_bit_cast(float, h << 16); }
__device__ __forceinline__ float bflo(unsigned w) { return __builtin_bit_cast(float, w << 16); }
__device__ __forceinline__ float bfhi(unsigned w) { return __builtin_bit_cast(float, w & 0xffff0000u); }
__device__ __forceinline__ float wave_sum(float v) {
#pragma unroll
    for (int o = 1; o < 64; o <<= 1) v += __shfl_xor(v, o);
    return v;
}
__device__ __forceinline__ float wave_max(float v) {
#pragma unroll
    for (int o = 1; o < 64; o <<= 1) v = fmaxf(v, __shfl_xor(v, o));
    return v;
}
__device__ __forceinline__ float wave_min(float v) {
#pragma unroll
    for (int o = 1; o < 64; o <<= 1) v = fminf(v, __shfl_xor(v, o));
    return v;
}
#define XB_TMO      128
#define XB_XCNT(j)  (256  + 64 * (j))
#define XB_XSUB(j)  (1280 + 64 * (j))
#define XB_XGEN(j)  (2304 + 64 * (j))
#define XB_TOP      3328
#define XB_TOPGEN   3392
#define XCD_BAR_WORDS 3456
#define XB_SPIN_CAP (1u << 18)

__device__ __forceinline__ unsigned xb_ld(unsigned* p)              { return __hip_atomic_load(p, __ATOMIC_RELAXED, __HIP_MEMORY_SCOPE_AGENT); }
__device__ __forceinline__ unsigned xb_add(unsigned* p, unsigned v) { return __hip_atomic_fetch_add(p, v, __ATOMIC_RELAXED, __HIP_MEMORY_SCOPE_AGENT); }
__device__ __forceinline__ unsigned xb_xcc_id() { return (unsigned)__builtin_amdgcn_s_getreg((3 << 11) | 20) & 0xFu; }
#define XB_SPIN(cond, bar) do { unsigned _sp = 0; while (cond) { __builtin_amdgcn_s_sleep(1); \
    if ((++_sp & 255u) == 0u) { if (xb_ld(&(bar)[XB_TMO])) break; if (_sp > XB_SPIN_CAP) { atomicAdd(&(bar)[XB_TMO], 1u); break; } } } } while (0)

struct XcdBarrier {
    unsigned* bar; unsigned x;
    volatile LAS unsigned* st;
};

__device__ __forceinline__ XcdBarrier xcd_barrier_post(unsigned* bar, volatile LAS unsigned* st) {
    XcdBarrier b; b.bar = bar; b.x = xb_xcc_id(); b.st = st;
    if (threadIdx.x == 0) (void)xb_add(&bar[XB_XCNT(b.x)], 1u);
    return b;
}
__device__ __forceinline__ void xcd_barrier_complete(unsigned* bar, unsigned x, unsigned& nloc, unsigned& nx) {
    const unsigned G = gridDim.x * gridDim.y * gridDim.z;
    unsigned sum, cnt, mine, sp = 0u;
    for (;;) {
        sum = 0u; cnt = 0u; mine = 0u;
#pragma unroll
        for (unsigned j = 0; j < 16; ++j) { const unsigned c = xb_ld(&bar[XB_XCNT(j)]); sum += c; cnt += (c > 0u) ? 1u : 0u; mine = (j == x) ? c : mine; }
        if (sum == G) break;
        __builtin_amdgcn_s_sleep(1);
        if ((++sp & 255u) == 0u) { if (xb_ld(&bar[XB_TMO])) break; if (sp > XB_SPIN_CAP) { atomicAdd(&bar[XB_TMO], 1u); break; } }
    }
    nloc = mine > 0u ? mine : 1u; nx = cnt > 0u ? cnt : 1u;
}

__device__ __forceinline__ void xcd_barrier(const XcdBarrier& b) {
    asm volatile("s_waitcnt vmcnt(0)" ::: "memory");
    __syncthreads();
    if (threadIdx.x == 0) {
        unsigned* bar = b.bar;
        __builtin_amdgcn_s_waitcnt(0);
        unsigned nloc = b.st[0], nx = b.st[1];
        if (nloc == 0u) { xcd_barrier_complete(bar, b.x, nloc, nx); b.st[0] = nloc; b.st[1] = nx; }
        const unsigned old = xb_add(&bar[XB_XSUB(b.x)], 1u);
        const unsigned gen = old / nloc;
        if (old + 1u == (gen + 1u) * nloc) {
            __builtin_amdgcn_fence(__ATOMIC_RELEASE, "agent");
            asm volatile("s_waitcnt vmcnt(0)" ::: "memory");
            const unsigned og = xb_add(&bar[XB_TOP], 1u);
            const unsigned tg = og / nx;
            if (og + 1u == (tg + 1u) * nx) xb_add(&bar[XB_TOPGEN], 1u);
            else XB_SPIN(xb_ld(&bar[XB_TOPGEN]) == tg, bar);
            __builtin_amdgcn_fence(__ATOMIC_ACQUIRE, "agent");
            xb_add(&bar[XB_XGEN(b.x)], 1u);
            asm volatile("s_waitcnt vmcnt(0)" ::: "memory");
        } else {
            XB_SPIN(xb_ld(&bar[XB_XGEN(b.x)]) == gen, bar);
            __builtin_amdgcn_fence(__ATOMIC_ACQUIRE, "agent");
            asm volatile("s_waitcnt vmcnt(0)" ::: "memory");
        }
    }
    __syncthreads();
}

struct Args { const float* in[18]; float* out; unsigned char* ws; int ph_lo, ph_hi, sub, qrep; };
struct Ctx {
    LAS unsigned char* lds; int tid, lane, wave, bid, G;
    unsigned char* ws; float* out;
};
__device__ __forceinline__ int q_next(const Ctx& C, gu32* head) {
    volatile LAS unsigned* slot = (volatile LAS unsigned*)(C.lds + MISC_OFF) + 2;
    __syncthreads();
    if (C.tid == 0) *slot = __hip_atomic_fetch_add(head, 1u, RLX_AGENT);
    __syncthreads();
    return (int)*slot;
}

__device__ __forceinline__ int win_src_col(int d) {
    if (d < 2176) return d;
    if (d < 4224) return d + 4;
    if (d < 8320) return d + 20;
    if (d < 12416) return d + 36;
    if (d < 12420) return 2176 + (d - 12416);
    if (d < 12436) return 4228 + (d - 12420);
    if (d < 12452) return 8340 + (d - 12436);
    return -1;
}
__device__ __forceinline__ void transpose_item(const float* W, int K, int N, bf16* WT, int ndest, bool mapped, LAS float* scr, int item, int lane) {
    const int nblk = ndest / 32, kb = item / nblk, nb = item % nblk, k0 = 64 * kb, n0 = 32 * nb;
    const int src = mapped ? win_src_col(n0 + (lane & 31)) : n0 + (lane & 31);
    float wv[32];
#pragma unroll
    for (int i = 0; i < 32; ++i) { const int kk = 2 * i + (lane >> 5); wv[i] = src >= 0 ? __builtin_nontemporal_load(W + (size_t)(k0 + kk) * N + src) : 0.f; }
#pragma unroll
    for (int i = 0; i < 32; ++i) { const int kk = 2 * i + (lane >> 5); scr[kk * 33 + (lane & 31)] = wv[i]; }
    LDS_WAIT(); asm volatile("" ::: "memory");
    const int c = lane & 7;
#pragma unroll
    for (int j = 0; j < 4; ++j) { const int n = (lane >> 3) + 8 * j; const LAS float* s = scr + (8 * c) * 33 + n;
        v4u o; o.x = pk2(s[0 * 33], s[1 * 33]); o.y = pk2(s[2 * 33], s[3 * 33]); o.z = pk2(s[4 * 33], s[5 * 33]); o.w = pk2(s[6 * 33], s[7 * 33]);
        *(GAS v4u*)(WT + (size_t)(n0 + n) * K + k0 + 8 * c) = o; }
    LDS_WAIT(); asm volatile("" ::: "memory");
}
__device__ __forceinline__ void sincos_own(double a, float& co, float& si) {
    const double k = __builtin_rint(a * 0.6366197723675814);
    const double r = __builtin_fma(-k, 1.5707963267948966, a) - k * 6.123233995736766e-17;
    const int q = ((int)k) & 3;
    const double r2 = r * r;
    double sp = 1.6059043836821613e-10; sp = sp * r2 - 2.505210838544172e-08; sp = sp * r2 + 2.7557319223985893e-06; sp = sp * r2 - 0.0001984126984126984; sp = sp * r2 + 0.008333333333333333; sp = sp * r2 - 0.16666666666666666; sp = sp * r2 * r + r;
    double cp = -1.1470745597729725e-11; cp = cp * r2 + 2.08767569878681e-09; cp = cp * r2 - 2.755731922398589e-07; cp = cp * r2 + 2.48015873015873e-05; cp = cp * r2 - 0.001388888888888889; cp = cp * r2 + 0.041666666666666664; cp = cp * r2 - 0.5; cp = cp * r2 + 1.0;
    const double cc = (q == 0) ? cp : (q == 1) ? -sp : (q == 2) ? -cp : sp;
    const double ss = (q == 0) ? sp : (q == 1) ? cp : (q == 2) ? -sp : -cp;
    co = (float)cc; si = (float)ss;
}
__device__ __forceinline__ void ln_row(const float* xrow, float* orow, bf16* obrow, float* st, const float* g, const float* b, int lane) {
    const GAS f32x4* xr = (const GAS f32x4*)xrow + lane;
    f32x4 v[16]; float s = 0.f;
#pragma unroll
    for (int j = 0; j < 16; ++j) { v[j] = xr[64 * j]; s += (v[j].x + v[j].y) + (v[j].z + v[j].w); }
    const float mean = wave_sum(s) * (1.f / D); float s2 = 0.f;
#pragma unroll
    for (int j = 0; j < 16; ++j) { v[j] = v[j] - mean; s2 += (v[j].x * v[j].x + v[j].y * v[j].y) + (v[j].z * v[j].z + v[j].w * v[j].w); }
    const float rstd = 1.f / sqrtf(wave_sum(s2) * (1.f / D) + LN_EPS);
    if (st && lane == 0) *(GAS f32x2*)st = (f32x2){mean, rstd};
    GAS f32x4* o4 = (GAS f32x4*)orow + lane; GAS v2u* o8 = (GAS v2u*)obrow + lane;
    const GAS f32x4* g4 = (const GAS f32x4*)g + lane; const GAS f32x4* b4 = (const GAS f32x4*)b + lane;
#pragma unroll
    for (int j = 0; j < 16; ++j) { const f32x4 o = v[j] * rstd * g4[64 * j] + b4[64 * j]; if (orow) o4[64 * j] = o; if (obrow) { v2u w; w.x = pk2(o.x, o.y); w.y = pk2(o.z, o.w); o8[64 * j] = w; } }
}
__device__ __forceinline__ void ln_phase(const Ctx& C, const float* src, float* dst, bf16* dstb, float* st, const float* g, const float* b) {
    const int gw = C.bid * NWAVES + C.wave, NGW = C.G * NWAVES;
    for (int m = gw; m < M; m += NGW) ln_row(src + (size_t)m * D, dst ? dst + (size_t)m * D : nullptr, dstb ? dstb + (size_t)m * D : nullptr, st ? st + 2 * m : nullptr, g, b, C.lane);
}
__device__ __forceinline__ void init_phase(const Ctx& C, const Args& A) {
    LAS float* scr = (LAS float*)(C.lds + C.wave * 16384);
    const int gw = C.bid * NWAVES + C.wave, NGW = C.G * NWAVES;
    constexpr int I_IN = (D / 64) * (LDZ / 32), I_OUT = (D / 64) * (D / 32), I_UP = (D / 64) * (DFF / 32), I_DN = (DFF / 64) * (D / 32);
    constexpr int I_LAYER = I_IN + I_OUT + I_UP + I_DN;
    for (int it = gw; it < NLAYER * I_LAYER; it += NGW) {
        const int l = it / I_LAYER; int r = it % I_LAYER;
        if (r < I_IN) { transpose_item(A.in[3] + (size_t)l * D * DIN, D, DIN, (bf16*)(C.ws + WS_WIN + l * WIN_BYTES), LDZ, true, scr, r, C.lane); continue; } r -= I_IN;
        if (r < I_OUT) { transpose_item(A.in[4] + (size_t)l * D * D, D, D, (bf16*)(C.ws + WS_WOUT + l * WOUT_BYTES), D, false, scr, r, C.lane); continue; } r -= I_OUT;
        if (r < I_UP) { transpose_item(A.in[14] + (size_t)l * D * DFF, D, DFF, (bf16*)(C.ws + WS_WUP + l * WUP_BYTES), DFF, false, scr, r, C.lane); continue; } r -= I_UP;
        transpose_item(A.in[15] + (size_t)l * DFF * D, DFF, D, (bf16*)(C.ws + WS_WDN + l * WDN_BYTES), D, false, scr, r, C.lane);
    }
    { f32x2* rope = (f32x2*)(C.ws + WS_ROPE);
      for (int idx = C.bid * NTHREADS + C.tid; idx < T * 64; idx += C.G * NTHREADS) {
          const int t = idx >> 6, i = idx & 63; double p = 1.0; for (int k = 0; k < i; ++k) p *= 0.8659643233600653;
          const float inv = (float)p; const float ang = (float)t * inv; float co, si; sincos_own((double)ang, co, si);
          rope[idx] = (f32x2){co, si}; } }
    ln_phase(C, A.in[0], nullptr, (bf16*)(C.ws + WS_HB), (float*)(C.ws + WS_STATS), A.in[1], A.in[2]);
}
#define MFMA16(a, b, c) __builtin_amdgcn_mfma_f32_16x16x32_bf16(a, b, c, 0, 0, 0)
#define MFMA32(a, b, c) __builtin_amdgcn_mfma_f32_32x32x16_bf16(a, b, c, 0, 0, 0)
__device__ __forceinline__ float log_sigmoidf(float x) { return fminf(x, 0.f) - log1pf(__expf(-fabsf(x))); }
__device__ __forceinline__ float siluf(float x) { return x / (1.f + __expf(-x)); }
constexpr int GL_GLR = 0, GL_W2H = 4096, GL_BIAS = 12288, GL_BCUM = 12800, GL_GT = 45568;
constexpr int G1_K2T = 47616, G1_VT = 66048;
constexpr int G3_QT = 47616, G3_KT = 65024, G3_VT = 82432, G3_ATT = 119296, G3_SS = 128512;
__device__ __forceinline__ void gla_bcum(const Ctx& C, const bf16* Z, const float* w2, const float* gb, int b, int h, int c) {
    LAS float* GLR = (LAS float*)(C.lds + GL_GLR); LAS float* W2H = (LAS float*)(C.lds + GL_W2H); LAS float* BIAS = (LAS float*)(C.lds + GL_BIAS);
    LAS float* BCUM = (LAS float*)(C.lds + GL_BCUM); LAS float* GT = (LAS float*)(C.lds + GL_GT);
    const size_t m0 = (size_t)b * T + (size_t)c * 64;
    for (int e = C.tid; e < 64 * 16; e += NTHREADS) { const int j = e >> 4, r = e & 15; GLR[e] = bf2f(Z[(m0 + j) * LDZ + ZS_GLR + r]); }
    for (int e = C.tid; e < 16 * 128; e += NTHREADS) { const int r = e >> 7, d = e & 127; W2H[e] = w2[r * 512 + h * 128 + d]; }
    if (C.tid < 128) BIAS[C.tid] = gb[h * 128 + C.tid];
    __syncthreads();
    const int d = C.tid & 127, grp = C.tid >> 7;
    float wcol[16];
#pragma unroll
    for (int r = 0; r < 16; ++r) wcol[r] = W2H[r * 128 + d];
    const float bi = BIAS[d];
    float cum[16]; float run = 0.f;
#pragma unroll
    for (int jj = 0; jj < 16; ++jj) { const int j = grp * 16 + jj; float x = bi;
#pragma unroll
        for (int r = 0; r < 16; ++r) x += GLR[j * 16 + r] * wcol[r];
        run += log_sigmoidf(x) * (1.f / 16.f); cum[jj] = run; }
    GT[grp * 128 + d] = run;
    __syncthreads();
    float off = 0.f;
#pragma unroll
    for (int g = 0; g < 3; ++g) if (g < grp) off += GT[g * 128 + d];
#pragma unroll
    for (int jj = 0; jj < 16; ++jj) BCUM[(grp * 16 + jj) * 128 + d] = cum[jj] + off;
    __syncthreads();
}
__device__ __forceinline__ void gla_b1_unit(const Ctx& C, const bf16* Z, const float* w2, const float* gb, int unit) {
    const int c = unit & 127, h = (unit >> 7) & 3, b = unit >> 9;
    gla_bcum(C, Z, w2, gb, b, h, c);
    LAS float* BCUM = (LAS float*)(C.lds + GL_BCUM); LAS bf16* K2T = (LAS bf16*)(C.lds + G1_K2T); LAS bf16* VT = (LAS bf16*)(C.lds + G1_VT);
    const size_t m0 = (size_t)b * T + (size_t)c * 64;
    for (int e = C.tid; e < 64 * 16; e += NTHREADS) { const int j = e >> 4, dg = e & 15;
        const v4u kv = *(const GAS v4u*)(Z + (m0 + j) * LDZ + ZB_K + h * 128 + dg * 8); const unsigned kw[4] = {kv.x, kv.y, kv.z, kv.w};
#pragma unroll
        for (int q = 0; q < 4; ++q) { const int d = dg * 8 + 2 * q;
            const float e0 = __expf(BCUM[63 * 128 + d] - BCUM[j * 128 + d]), e1 = __expf(BCUM[63 * 128 + d + 1] - BCUM[j * 128 + d + 1]);
            K2T[d * 72 + j] = (bf16)f2bf(bflo(kw[q]) * e0); K2T[(d + 1) * 72 + j] = (bf16)f2bf(bfhi(kw[q]) * e1); } }
    for (int e = C.tid; e < 64 * 32; e += NTHREADS) { const int j = e >> 5, vg = e & 31;
        const v4u vv = *(const GAS v4u*)(Z + (m0 + j) * LDZ + ZB_V + h * 256 + vg * 8); const unsigned vw[4] = {vv.x, vv.y, vv.z, vv.w};
#pragma unroll
        for (int q = 0; q < 4; ++q) { const int dv = vg * 8 + 2 * q; VT[dv * 72 + j] = (bf16)(vw[q] & 0xffffu); VT[(dv + 1) * 72 + j] = (bf16)(vw[q] >> 16); } }
    if (C.tid < 128) ((float*)(C.ws + WS_GLA_DL))[(size_t)unit * 128 + C.tid] = __expf(BCUM[63 * 128 + C.tid]);
    __syncthreads();
    const int row = C.lane & 15, kg = C.lane >> 4;
    f32x4 acc[2][8];
#pragma unroll
    for (int mt = 0; mt < 2; ++mt)
#pragma unroll
        for (int nt = 0; nt < 8; ++nt) acc[mt][nt] = (f32x4){0.f, 0.f, 0.f, 0.f};
#pragma unroll
    for (int ks = 0; ks < 2; ++ks) {
        bf16x8 af[2];
#pragma unroll
        for (int mt = 0; mt < 2; ++mt) af[mt] = *(const LAS bf16x8*)(VT + (C.wave * 32 + mt * 16 + row) * 72 + ks * 32 + kg * 8);
#pragma unroll
        for (int nt = 0; nt < 8; ++nt) { const bf16x8 bfr = *(const LAS bf16x8*)(K2T + (nt * 16 + row) * 72 + ks * 32 + kg * 8);
#pragma unroll
            for (int mt = 0; mt < 2; ++mt) acc[mt][nt] = MFMA16(af[mt], bfr, acc[mt][nt]); }
    }
    float* HT = (float*)(C.ws + WS_GLA_HT) + (size_t)unit * 256 * 128;
#pragma unroll
    for (int mt = 0; mt < 2; ++mt)
#pragma unroll
        for (int nt = 0; nt < 8; ++nt)
#pragma unroll
            for (int r = 0; r < 4; ++r) HT[(size_t)(C.wave * 32 + mt * 16 + kg * 4 + r) * 128 + nt * 16 + row] = acc[mt][nt][r];
    __syncthreads();
}
__device__ __forceinline__ void gla_b2_unit(const Ctx& C, int unit) {
    const int idx = unit * NTHREADS + C.tid; const int d4 = idx & 31, dv = (idx >> 5) & 255, bh = idx >> 13;
    const float* HT = (const float*)(C.ws + WS_GLA_HT) + ((size_t)bh * 128 * 256 + dv) * 128 + d4 * 4;
    const float* DL = (const float*)(C.ws + WS_GLA_DL) + (size_t)bh * 128 * 128 + d4 * 4;
    bf16* ST = (bf16*)(C.ws + WS_GLA_ST) + ((size_t)bh * 128 * 256 + dv) * 128 + d4 * 4;
    f32x4 S = (f32x4){0.f, 0.f, 0.f, 0.f};
#pragma unroll 4
    for (int c = 0; c < 128; ++c) {
        const f32x4 hv = *(const GAS f32x4*)(HT + (size_t)c * 256 * 128); const f32x4 dl = *(const GAS f32x4*)(DL + (size_t)c * 128);
        v2u w; w.x = pk2(S.x, S.y); w.y = pk2(S.z, S.w); *(GAS v2u*)(ST + (size_t)c * 256 * 128) = w;
        S = dl * S + hv;
    }
}
__device__ __forceinline__ void gla_b3_unit(const Ctx& C, const bf16* Z, bf16* MIX, const float* w2, const float* gb, const float* ng, int unit) {
    const int c = unit & 127, h = (unit >> 7) & 3, b = unit >> 9;
    gla_bcum(C, Z, w2, gb, b, h, c);
    LAS float* BCUM = (LAS float*)(C.lds + GL_BCUM); LAS bf16* QT = (LAS bf16*)(C.lds + G3_QT); LAS bf16* KT = (LAS bf16*)(C.lds + G3_KT);
    LAS bf16* VT = (LAS bf16*)(C.lds + G3_VT); LAS bf16* ATT = (LAS bf16*)(C.lds + G3_ATT); LAS float* SS = (LAS float*)(C.lds + G3_SS);
    const size_t m0 = (size_t)b * T + (size_t)c * 64;
    for (int e = C.tid; e < 64 * 16; e += NTHREADS) { const int j = e >> 4, dg = e & 15;
        const v4u qv = *(const GAS v4u*)(Z + (m0 + j) * LDZ + ZB_Q + h * 128 + dg * 8); const v4u kv = *(const GAS v4u*)(Z + (m0 + j) * LDZ + ZB_K + h * 128 + dg * 8);
        const unsigned qw[4] = {qv.x, qv.y, qv.z, qv.w}, kw[4] = {kv.x, kv.y, kv.z, kv.w}; unsigned qo[4], ko[4];
#pragma unroll
        for (int q = 0; q < 4; ++q) { const int d = dg * 8 + 2 * q; const float b0 = BCUM[j * 128 + d], b1 = BCUM[j * 128 + d + 1];
            qo[q] = pk2(bflo(qw[q]) * 0.08838834764831845f * __expf(b0), bfhi(qw[q]) * 0.08838834764831845f * __expf(b1));
            ko[q] = pk2(bflo(kw[q]) * __expf(-b0), bfhi(kw[q]) * __expf(-b1)); }
        *(LAS v4u*)(QT + j * 136 + dg * 8) = (v4u){qo[0], qo[1], qo[2], qo[3]}; *(LAS v4u*)(KT + j * 136 + dg * 8) = (v4u){ko[0], ko[1], ko[2], ko[3]}; }
    for (int e = C.tid; e < 64 * 32; e += NTHREADS) { const int j = e >> 5, vg = e & 31;
        const v4u vv = *(const GAS v4u*)(Z + (m0 + j) * LDZ + ZB_V + h * 256 + vg * 8); const unsigned vw[4] = {vv.x, vv.y, vv.z, vv.w};
#pragma unroll
        for (int q = 0; q < 4; ++q) { const int dv = vg * 8 + 2 * q; VT[dv * 72 + j] = (bf16)(vw[q] & 0xffffu); VT[(dv + 1) * 72 + j] = (bf16)(vw[q] >> 16); } }
    __syncthreads();
    const int row = C.lane & 15, kg = C.lane >> 4;
    {
        const int mt = C.wave >> 1; f32x4 a2[2] = {(f32x4){0.f, 0.f, 0.f, 0.f}, (f32x4){0.f, 0.f, 0.f, 0.f}};
#pragma unroll
        for (int ks = 0; ks < 4; ++ks) { const bf16x8 af = *(const LAS bf16x8*)(QT + (mt * 16 + row) * 136 + ks * 32 + kg * 8);
#pragma unroll
            for (int n2 = 0; n2 < 2; ++n2) { const int nt = (C.wave & 1) * 2 + n2; const bf16x8 bfr = *(const LAS bf16x8*)(KT + (nt * 16 + row) * 136 + ks * 32 + kg * 8); a2[n2] = MFMA16(af, bfr, a2[n2]); } }
#pragma unroll
        for (int n2 = 0; n2 < 2; ++n2) { const int j = ((C.wave & 1) * 2 + n2) * 16 + row;
#pragma unroll
            for (int r = 0; r < 4; ++r) { const int i = mt * 16 + kg * 4 + r; ATT[i * 72 + j] = (bf16)f2bf(j <= i ? a2[n2][r] : 0.f); } }
    }
    __syncthreads();
    const int wr = C.wave >> 2, wc = C.wave & 3;
    f32x4 acc[2][4];
#pragma unroll
    for (int mt = 0; mt < 2; ++mt)
#pragma unroll
        for (int nt = 0; nt < 4; ++nt) acc[mt][nt] = (f32x4){0.f, 0.f, 0.f, 0.f};
#pragma unroll
    for (int ks = 0; ks < 2; ++ks) { bf16x8 af[2];
#pragma unroll
        for (int mt = 0; mt < 2; ++mt) af[mt] = *(const LAS bf16x8*)(ATT + (wr * 32 + mt * 16 + row) * 72 + ks * 32 + kg * 8);
#pragma unroll
        for (int nt = 0; nt < 4; ++nt) { const bf16x8 bfr = *(const LAS bf16x8*)(VT + (wc * 64 + nt * 16 + row) * 72 + ks * 32 + kg * 8);
#pragma unroll
            for (int mt = 0; mt < 2; ++mt) acc[mt][nt] = MFMA16(af[mt], bfr, acc[mt][nt]); } }
    const bf16* ST = (const bf16*)(C.ws + WS_GLA_ST) + (size_t)unit * 256 * 128;
#pragma unroll
    for (int ks = 0; ks < 4; ++ks) { bf16x8 af[2];
#pragma unroll
        for (int mt = 0; mt < 2; ++mt) af[mt] = *(const LAS bf16x8*)(QT + (wr * 32 + mt * 16 + row) * 136 + ks * 32 + kg * 8);
#pragma unroll
        for (int nt = 0; nt < 4; ++nt) { const bf16x8 bfr = *(const GAS bf16x8*)(ST + (size_t)(wc * 64 + nt * 16 + row) * 128 + ks * 32 + kg * 8);
#pragma unroll
            for (int mt = 0; mt < 2; ++mt) acc[mt][nt] = MFMA16(af[mt], bfr, acc[mt][nt]); } }
#pragma unroll
    for (int mt = 0; mt < 2; ++mt)
#pragma unroll
        for (int r = 0; r < 4; ++r) { float s = 0.f;
#pragma unroll
            for (int nt = 0; nt < 4; ++nt) s += acc[mt][nt][r] * acc[mt][nt][r];
            s += __shfl_xor(s, 1); s += __shfl_xor(s, 2); s += __shfl_xor(s, 4); s += __shfl_xor(s, 8);
            if (row == 0) SS[(wr * 32 + mt * 16 + kg * 4 + r) * 4 + wc] = s; }
    __syncthreads();
#pragma unroll
    for (int mt = 0; mt < 2; ++mt)
#pragma unroll
        for (int r = 0; r < 4; ++r) { const int i = wr * 32 + mt * 16 + kg * 4 + r; const f32x4 s4 = *(const LAS f32x4*)(SS + i * 4);
            const float rstd = 1.f / sqrtf(((s4.x + s4.y) + (s4.z + s4.w)) * (1.f / 256.f) + NORM_EPS);
#pragma unroll
            for (int nt = 0; nt < 4; ++nt) { const int dv = wc * 64 + nt * 16 + row;
                const float gate = siluf(bf2f(Z[(m0 + i) * LDZ + ZB_R + h * 256 + dv]));
                MIX[(m0 + i) * D + MX_B + h * 256 + dv] = (bf16)f2bf(acc[mt][nt][r] * rstd * ng[dv] * gate); } }
    __syncthreads();
}
constexpr int C1_GAM = 0, C1_BETA = 256, C1_AM = 1024, C1_KF = 17408, C1_VF = 50176, C1_QB = 82944, C1_KB = 100352, C1_AQK = 117760;
constexpr int C1_WB = 17408, C1_QH = 34816, C1_KHT = 52224;
__device__ __forceinline__ float softplusf(float x) { return fmaxf(x, 0.f) + log1pf(__expf(-fabsf(x))); }
__device__ __forceinline__ void gdn_c1_unit(const Ctx& C, const bf16* Z, const float* convw, const float* alog, const float* dtb, int unit) {
    const int c = unit & 127, h = (unit >> 7) & 7, b = unit >> 10;
    LAS float* GAM = (LAS float*)(C.lds + C1_GAM); LAS float* BETA = (LAS float*)(C.lds + C1_BETA);
    LAS float* KF = (LAS float*)(C.lds + C1_KF); LAS float* VF = (LAS float*)(C.lds + C1_VF);
    LAS bf16* QB = (LAS bf16*)(C.lds + C1_QB); LAS bf16* KB = (LAS bf16*)(C.lds + C1_KB);
    LAS float* AM = (LAS float*)(C.lds + C1_AM); LAS bf16* AQK = (LAS bf16*)(C.lds + C1_AQK);
    const size_t m0 = (size_t)b * T + (size_t)c * 64;
    for (int e = C.tid; e < 64 * 16; e += NTHREADS) { const int t = e >> 4, dg = e & 15;
        float val[3][8];
#pragma unroll
        for (int p = 0; p < 3; ++p) { const int zc = (p == 0 ? ZC_Q : p == 1 ? ZC_K : ZC_V) + h * 128 + dg * 8; const int ch = p * 1024 + h * 128 + dg * 8;
#pragma unroll
            for (int q = 0; q < 8; ++q) val[p][q] = 0.f;
#pragma unroll
            for (int i = 0; i < 4; ++i) { const int tt = c * 64 + t - 3 + i;
                if (tt >= 0) { const v4u xv = *(const GAS v4u*)(Z + ((size_t)b * T + tt) * LDZ + zc); const unsigned xw[4] = {xv.x, xv.y, xv.z, xv.w};
                    const f32x4 w0 = *(const GAS f32x4*)(convw + i * 3072 + ch), w1 = *(const GAS f32x4*)(convw + i * 3072 + ch + 4);
                    val[p][0] += bflo(xw[0]) * w0.x; val[p][1] += bfhi(xw[0]) * w0.y; val[p][2] += bflo(xw[1]) * w0.z; val[p][3] += bfhi(xw[1]) * w0.w;
                    val[p][4] += bflo(xw[2]) * w1.x; val[p][5] += bfhi(xw[2]) * w1.y; val[p][6] += bflo(xw[3]) * w1.z; val[p][7] += bfhi(xw[3]) * w1.w; } }
#pragma unroll
            for (int q = 0; q < 8; ++q) val[p][q] = siluf(val[p][q]); }
        float sq = 0.f, sk = 0.f;
#pragma unroll
        for (int q = 0; q < 8; ++q) { sq += val[0][q] * val[0][q]; sk += val[1][q] * val[1][q]; }
        sq += __shfl_xor(sq, 1); sq += __shfl_xor(sq, 2); sq += __shfl_xor(sq, 4); sq += __shfl_xor(sq, 8);
        sk += __shfl_xor(sk, 1); sk += __shfl_xor(sk, 2); sk += __shfl_xor(sk, 4); sk += __shfl_xor(sk, 8);
        const float rq = 0.08838834764831845f / sqrtf(sq + NORM_EPS), rk = 1.f / sqrtf(sk + NORM_EPS);
#pragma unroll
        for (int q = 0; q < 8; ++q) { val[0][q] *= rq; val[1][q] *= rk; }
        *(LAS f32x4*)(KF + t * 128 + dg * 8) = (f32x4){val[1][0], val[1][1], val[1][2], val[1][3]}; *(LAS f32x4*)(KF + t * 128 + dg * 8 + 4) = (f32x4){val[1][4], val[1][5], val[1][6], val[1][7]};
        *(LAS f32x4*)(VF + t * 128 + dg * 8) = (f32x4){val[2][0], val[2][1], val[2][2], val[2][3]}; *(LAS f32x4*)(VF + t * 128 + dg * 8 + 4) = (f32x4){val[2][4], val[2][5], val[2][6], val[2][7]};
        *(LAS v4u*)(QB + t * 136 + dg * 8) = (v4u){pk2(val[0][0], val[0][1]), pk2(val[0][2], val[0][3]), pk2(val[0][4], val[0][5]), pk2(val[0][6], val[0][7])};
        *(LAS v4u*)(KB + t * 136 + dg * 8) = (v4u){pk2(val[1][0], val[1][1]), pk2(val[1][2], val[1][3]), pk2(val[1][4], val[1][5]), pk2(val[1][6], val[1][7])}; }
    if (C.wave == 0) { const int t = C.lane;
        const float cb = bf2f(Z[(m0 + t) * LDZ + ZS_CB + h]), ca = bf2f(Z[(m0 + t) * LDZ + ZS_CA + h]);
        const float beta = 1.f / (1.f + __expf(-cb)); float g = -__expf(alog[h]) * softplusf(ca + dtb[h]);
#pragma unroll
        for (int o = 1; o < 64; o <<= 1) { const float n = __shfl_up(g, o); if (C.lane >= o) g += n; }
        GAM[t] = g; BETA[t] = beta; }
    __syncthreads();
    const int row = C.lane & 15, kg = C.lane >> 4;
    {
        const int mt = C.wave >> 1; f32x4 akk[2], aqk[2];
#pragma unroll
        for (int n2 = 0; n2 < 2; ++n2) { akk[n2] = (f32x4){0.f, 0.f, 0.f, 0.f}; aqk[n2] = (f32x4){0.f, 0.f, 0.f, 0.f}; }
#pragma unroll
        for (int ks = 0; ks < 4; ++ks) { const bf16x8 ak = *(const LAS bf16x8*)(KB + (mt * 16 + row) * 136 + ks * 32 + kg * 8), aq = *(const LAS bf16x8*)(QB + (mt * 16 + row) * 136 + ks * 32 + kg * 8);
#pragma unroll
            for (int n2 = 0; n2 < 2; ++n2) { const int nt = (C.wave & 1) * 2 + n2; const bf16x8 bfr = *(const LAS bf16x8*)(KB + (nt * 16 + row) * 136 + ks * 32 + kg * 8);
                akk[n2] = MFMA16(ak, bfr, akk[n2]); aqk[n2] = MFMA16(aq, bfr, aqk[n2]); } }
#pragma unroll
        for (int n2 = 0; n2 < 2; ++n2) { const int j = ((C.wave & 1) * 2 + n2) * 16 + row; const float gj = GAM[j];
#pragma unroll
            for (int r = 0; r < 4; ++r) { const int i = mt * 16 + kg * 4 + r; const float dec = (j <= i) ? __expf(GAM[i] - gj) : 0.f;
                AM[i * 64 + j] = (j < i) ? BETA[i] * dec * akk[n2][r] : 0.f; AQK[i * 72 + j] = (bf16)f2bf(aqk[n2][r] * dec); } }
    }
    __syncthreads();
    float x[64];
    if (C.tid < 256) { const int cc = C.tid & 127; const bool isw = C.tid >= 128;
#pragma unroll
        for (int i = 0; i < 64; ++i) x[i] = isw ? BETA[i] * __expf(GAM[i]) * KF[i * 128 + cc] : BETA[i] * VF[i * 128 + cc]; }
    __syncthreads();
    if (C.tid < 256) {
#pragma unroll
        for (int i = 1; i < 64; ++i) { float s0 = 0.f, s1 = 0.f;
#pragma unroll
            for (int j4 = 0; j4 < (i + 3) / 4; ++j4) { const f32x4 a = *(const LAS f32x4*)(AM + i * 64 + j4 * 4);
                s0 += a.x * x[j4 * 4]; s1 += a.y * x[j4 * 4 + 1]; s0 += a.z * x[j4 * 4 + 2]; s1 += a.w * x[j4 * 4 + 3]; }
            x[i] -= (s0 + s1); asm volatile("" ::: "memory"); }
        const int cc = C.tid & 127;
        if (C.tid < 128) { float* UT = (float*)(C.ws + WS_GDN_UT) + ((size_t)unit * 128 + cc) * 64;
#pragma unroll
            for (int i4 = 0; i4 < 16; ++i4) *(GAS f32x4*)(UT + i4 * 4) = (f32x4){x[i4 * 4], x[i4 * 4 + 1], x[i4 * 4 + 2], x[i4 * 4 + 3]}; }
        else { LAS bf16* WB = (LAS bf16*)(C.lds + C1_WB);
#pragma unroll
            for (int i = 0; i < 64; ++i) WB[i * 136 + cc] = (bf16)f2bf(x[i]); }
    } else {
        LAS bf16* QH = (LAS bf16*)(C.lds + C1_QH); LAS bf16* KHT = (LAS bf16*)(C.lds + C1_KHT); const float gl = GAM[63];
        for (int e = C.tid - 256; e < 64 * 16; e += 256) { const int i = e >> 4, dg = e & 15; const float eq = __expf(GAM[i]), ek = __expf(gl - GAM[i]);
            const v4u qv = *(const LAS v4u*)(QB + i * 136 + dg * 8), kv = *(const LAS v4u*)(KB + i * 136 + dg * 8); const unsigned qw[4] = {qv.x, qv.y, qv.z, qv.w}, kw[4] = {kv.x, kv.y, kv.z, kv.w};
            *(LAS v4u*)(QH + i * 136 + dg * 8) = (v4u){pk2(bflo(qw[0]) * eq, bfhi(qw[0]) * eq), pk2(bflo(qw[1]) * eq, bfhi(qw[1]) * eq), pk2(bflo(qw[2]) * eq, bfhi(qw[2]) * eq), pk2(bflo(qw[3]) * eq, bfhi(qw[3]) * eq)};
#pragma unroll
            for (int q = 0; q < 4; ++q) { KHT[(dg * 8 + 2 * q) * 72 + i] = (bf16)f2bf(bflo(kw[q]) * ek); KHT[(dg * 8 + 2 * q + 1) * 72 + i] = (bf16)f2bf(bfhi(kw[q]) * ek); } }
        if (C.tid == 256) ((float*)(C.ws + WS_GDN_DL))[unit] = __expf(gl);
    }
    __syncthreads();
    {   LAS bf16* WB = (LAS bf16*)(C.lds + C1_WB); LAS bf16* QH = (LAS bf16*)(C.lds + C1_QH); LAS bf16* KHT = (LAS bf16*)(C.lds + C1_KHT);
        bf16* FR = (bf16*)(C.ws + WS_GDN_FR) + (size_t)unit * 28672;
        const int r = C.lane & 31, hh = C.lane >> 5;
        for (int i = C.wave; i < 54; i += NWAVES) { const LAS bf16* src; const int f = i < 24 ? i : i < 26 ? 24 + i : i < 34 ? i - 2 : i < 38 ? 18 + i : i - 6;
            if (f < 32) { const int g = f & 15, mt = g >> 3, t = (g >> 1) & 3, s = g & 1; src = (f < 16 ? WB : QH) + (32 * mt + r) * 136 + 32 * t + 16 * s + 4 * hh; }
            else if (f < 48) { const int g = f - 32, t = g >> 2, mt = (g >> 1) & 1, s = g & 1; src = KHT + (32 * t + r) * 72 + 32 * mt + 16 * s + 4 * hh; }
            else { const int g = f - 48, mt = g >> 2, mj = (g >> 1) & 1, s = g & 1; src = AQK + (32 * mt + r) * 72 + 32 * mj + 16 * s + 4 * hh; }
            const v2u lo = *(const LAS v2u*)src, hi2 = *(const LAS v2u*)(src + 8);
            *(GAS v4u*)(FR + ((size_t)i * 64 + C.lane) * 8) = (v4u){lo.x, lo.y, hi2.x, hi2.y}; }
    }
    __syncthreads();
}
__device__ __forceinline__ v4u pack8(const f32x16& a, int s) {
    v4u o; o.x = pk2(a[8 * s + 0], a[8 * s + 1]); o.y = pk2(a[8 * s + 2], a[8 * s + 3]); o.z = pk2(a[8 * s + 4], a[8 * s + 5]); o.w = pk2(a[8 * s + 6], a[8 * s + 7]); return o;
}
__device__ __forceinline__ void gdn_c2_wave(const Ctx& C, int bh, int slice, float* Oall) {
    const int b = bh >> 3, h = bh & 7; const int col = C.lane & 31, hh = C.lane >> 5;
    f32x16 S[4];
#pragma unroll
    for (int t = 0; t < 4; ++t)
#pragma unroll
        for (int r = 0; r < 16; ++r) S[t][r] = 0.f;
    const __amdgpu_buffer_rsrc_t rF = __builtin_amdgcn_make_buffer_rsrc((void*)((bf16*)(C.ws + WS_GDN_FR) + (size_t)bh * 128 * 28672), 0, 128 * 57344, 0x00020000);
    const __amdgpu_buffer_rsrc_t rU = __builtin_amdgcn_make_buffer_rsrc((void*)((float*)(C.ws + WS_GDN_UT) + (size_t)bh * 128 * 128 * 64), 0, 128 * 128 * 64 * 4, 0x00020000);
    const __amdgpu_buffer_rsrc_t rO = __builtin_amdgcn_make_buffer_rsrc((void*)(Oall + (size_t)b * T * 1024), 0, T * 1024 * 4, 0x00020000);
    const float* DLb = (const float*)(C.ws + WS_GDN_DL) + (size_t)bh * 128;
    const int vF = C.lane * 16, vU = ((slice * 32 + col) * 64 + 4 * hh) * 4, vO = (h * 128 + slice * 32 + col) * 4 + hh * 4 * 4096;
    constexpr int GW = 14, NSL = 56;
    bf16x8 win[GW]; f32x4 ur[2][4];
#define FLOAD(off) __builtin_bit_cast(bf16x8, __builtin_amdgcn_raw_buffer_load_b128(rF, vF, (off), 0))
#define ULOAD(su, mt, q) __builtin_bit_cast(f32x4, __builtin_amdgcn_raw_buffer_load_b128(rU, vU, (su) + (32 * (mt) + 8 * (q)) * 4, 0))
#pragma unroll
    for (int i = 0; i < GW; ++i) win[i] = FLOAD(i * 1024);
#pragma unroll
    for (int mt = 0; mt < 2; ++mt)
#pragma unroll
        for (int q = 0; q < 4; ++q) ur[mt][q] = ULOAD(0, mt, q);
    for (int c = 0; c < 128; ++c) {
        const int cn = c < 127 ? c + 1 : 127; const int sF = c * 57344, sFn = cn * 57344, sUn = cn * 32768, sO = c * 64 * 4096;
#define NEXTF(i) ({ const bf16x8 r_ = win[(i) % GW]; win[(i) % GW] = FLOAD(((i) + GW < NSL) ? sF + ((i) + GW) * 1024 : sFn + ((i) + GW - NSL) * 1024); r_; })
        bf16x8 Sb[4][2];
#pragma unroll
        for (int t = 0; t < 4; ++t)
#pragma unroll
            for (int s = 0; s < 2; ++s) Sb[t][s] = __builtin_bit_cast(bf16x8, pack8(S[t], s));
        bf16x8 Db[2][2];
#pragma unroll
        for (int mt = 0; mt < 2; ++mt) { f32x16 dl;
#pragma unroll
            for (int r = 0; r < 16; ++r) dl[r] = 0.f;
#pragma unroll
            for (int t = 0; t < 4; ++t)
#pragma unroll
                for (int s = 0; s < 2; ++s) dl = MFMA32(NEXTF(mt * 8 + t * 2 + s), Sb[t][s], dl);
#pragma unroll
            for (int q = 0; q < 4; ++q) { const f32x4 u = ur[mt][q]; ur[mt][q] = ULOAD(sUn, mt, q);
                dl[4 * q + 0] = u.x - dl[4 * q + 0]; dl[4 * q + 1] = u.y - dl[4 * q + 1]; dl[4 * q + 2] = u.z - dl[4 * q + 2]; dl[4 * q + 3] = u.w - dl[4 * q + 3]; }
#pragma unroll
            for (int s = 0; s < 2; ++s) Db[mt][s] = __builtin_bit_cast(bf16x8, pack8(dl, s));
        }
#pragma unroll
        for (int t = 0; t < 4; ++t)
#pragma unroll
            for (int r = 0; r < 16; ++r) asm volatile("" : "+v"(S[t][r]));
#pragma unroll
        for (int t = 0; t < 4; ++t)
#pragma unroll
            for (int s = 0; s < 2; ++s) Sb[t][s] = __builtin_bit_cast(bf16x8, pack8(S[t], s));
#pragma unroll
        for (int mt = 0; mt < 2; ++mt) { f32x16 o;
#pragma unroll
            for (int r = 0; r < 16; ++r) o[r] = 0.f;
#pragma unroll
            for (int t = 0; t < 4; ++t)
#pragma unroll
                for (int s = 0; s < 2; ++s) o = MFMA32(NEXTF((mt == 0 ? 16 : 26) + t * 2 + s), Sb[t][s], o);
#pragma unroll
            for (int mj = 0; mj <= mt; ++mj)
#pragma unroll
                for (int s = 0; s < 2; ++s) o = MFMA32(NEXTF((mt == 0 ? 24 : 34) + mj * 2 + s), Db[mj][s], o);
#pragma unroll
            for (int r = 0; r < 16; ++r) __builtin_amdgcn_raw_buffer_store_b32(__float_as_uint(o[r]), rO, vO, sO + (32 * mt + (r & 3) + 8 * (r >> 2)) * 4096, 0);
        }
        const float dlast = DLb[c];
#pragma unroll
        for (int t = 0; t < 4; ++t) {
#pragma unroll
            for (int r = 0; r < 16; ++r) S[t][r] *= dlast;
#pragma unroll
            for (int mt = 0; mt < 2; ++mt)
#pragma unroll
                for (int s = 0; s < 2; ++s) S[t] = MFMA32(NEXTF(38 + t * 4 + mt * 2 + s), Db[mt][s], S[t]);
        }
        (void)NEXTF(54); (void)NEXTF(55);
#undef NEXTF
    }
#undef FLOAD
#undef ULOAD
}
__device__ __forceinline__ void gdn_c3(const Ctx& C, const bf16* Z, bf16* MIX, const float* ng) {
    const float* O = (const float*)(C.ws + WS_GDN_O);
    for (size_t e = (size_t)C.bid * NTHREADS + C.tid; e < (size_t)M * 8 * 16; e += (size_t)C.G * NTHREADS) {
        const int dg = (int)(e & 15), h = (int)((e >> 4) & 7); const size_t m = e >> 7;
        const f32x4 o0 = *(const GAS f32x4*)(O + m * 1024 + h * 128 + dg * 8), o1 = *(const GAS f32x4*)(O + m * 1024 + h * 128 + dg * 8 + 4);
        float s = (o0.x * o0.x + o0.y * o0.y) + (o0.z * o0.z + o0.w * o0.w) + (o1.x * o1.x + o1.y * o1.y) + (o1.z * o1.z + o1.w * o1.w);
        s += __shfl_xor(s, 1); s += __shfl_xor(s, 2); s += __shfl_xor(s, 4); s += __shfl_xor(s, 8);
        const float rstd = 1.f / sqrtf(s * (1.f / 128.f) + NORM_EPS);
        const v4u gv = *(const GAS v4u*)(Z + m * LDZ + ZC_G + h * 128 + dg * 8); const f32x4 g0 = *(const GAS f32x4*)(ng + dg * 8), g1 = *(const GAS f32x4*)(ng + dg * 8 + 4);
        v4u w; w.x = pk2(o0.x * rstd * g0.x * siluf(bflo(gv.x)), o0.y * rstd * g0.y * siluf(bfhi(gv.x))); w.y = pk2(o0.z * rstd * g0.z * siluf(bflo(gv.y)), o0.w * rstd * g0.w * siluf(bfhi(gv.y)));
        w.z = pk2(o1.x * rstd * g1.x * siluf(bflo(gv.z)), o1.y * rstd * g1.y * siluf(bfhi(gv.z))); w.w = pk2(o1.z * rstd * g1.z * siluf(bflo(gv.w)), o1.w * rstd * g1.w * siluf(bfhi(gv.w)));
        *(GAS v4u*)(MIX + m * D + MX_C + h * 128 + dg * 8) = w;
    }
}
__device__ __forceinline__ int rope_slot_col(int s) { return s < 8 ? ZA_Q + 128 * s : s < 10 ? ZA_K + 128 * (s - 8) : s < 14 ? ZA_IQ + 128 * (s - 10) : s < 15 ? ZA_IK : s < 23 ? ZD_Q + 128 * (s - 15) : ZD_K + 128 * (s - 23); }
__device__ __forceinline__ void rope_phase(const Ctx& C, bf16* Z, long zd, long ikd, int w0, int nw) {
    const f32x4* rope = (const f32x4*)(C.ws + WS_ROPE);
    for (size_t e = (size_t)(C.bid - w0) * NTHREADS + C.tid; e < (size_t)M * 31 * 8; e += (size_t)nw * NTHREADS) {
        const int p = (int)(e & 7); const size_t ms = e >> 3; const int s = (int)(ms % 31); const size_t m = ms / 31; const int t = (int)(m & (T - 1));
        bf16* zp = Z + m * LDZ + rope_slot_col(s) + 8 * p;
        const v4u a = *(const GAS v4u*)zp, bq = *(const GAS v4u*)(zp + 64); const unsigned aw[4] = {a.x, a.y, a.z, a.w}, bw[4] = {bq.x, bq.y, bq.z, bq.w}; unsigned o1[4], o2[4];
#pragma unroll
        for (int q = 0; q < 4; ++q) { const f32x4 cs = rope[(size_t)t * 32 + 4 * p + q];
            const float x1a = bflo(aw[q]), x1b = bfhi(aw[q]), x2a = bflo(bw[q]), x2b = bfhi(bw[q]);
            o1[q] = pk2(x1a * cs.x - x2a * cs.y, x1b * cs.z - x2b * cs.w); o2[q] = pk2(x2a * cs.x + x1a * cs.y, x2b * cs.z + x1b * cs.w); }
        *(GAS v4u*)(zp + zd) = (v4u){o1[0], o1[1], o1[2], o1[3]}; *(GAS v4u*)(zp + zd + 64) = (v4u){o2[0], o2[1], o2[2], o2[3]};
        if (s == 14) {
            bf16* ikp = (bf16*)(C.ws + WS_IK) + ikd + (((m >> 4) * 4 + (p >> 2)) * 64 + (p & 3) * 16 + (m & 15)) * 8; *(GAS v4u*)ikp = (v4u){o1[0], o1[1], o1[2], o1[3]}; *(GAS v4u*)(ikp + 2 * 512) = (v4u){o2[0], o2[1], o2[2], o2[3]}; }
    }
}
__device__ __forceinline__ void vt_unit(const Ctx& C, const bf16* Z, int unit) {
    const int tt = unit & 127, s = (unit >> 7) % 10, b = (unit >> 7) / 10;
    LAS bf16* TL = (LAS bf16*)C.lds;
    const int zc = s < 2 ? ZA_V + 128 * s : ZD_V + 128 * (s - 2);
    bf16* dst = s < 2 ? (bf16*)(C.ws + WS_VTA) + ((size_t)(b * 2 + s) * 128) * T : (bf16*)(C.ws + WS_VTD) + ((size_t)(b * 8 + (s - 2)) * 128) * T;
    __syncthreads();
    for (int e = C.tid; e < 1024; e += NTHREADS) { const int j = e >> 4, pc = e & 15; *(LAS v4u*)(TL + j * 136 + pc * 8) = *(const GAS v4u*)(Z + ((size_t)b * T + tt * 64 + j) * LDZ + zc + pc * 8); }
    __syncthreads();
    for (int e = C.tid; e < 1024; e += NTHREADS) { const int d = e >> 3, tg = e & 7; unsigned w[4];
#pragma unroll
        for (int q = 0; q < 4; ++q) { const int g4 = (tg & 1) * 2 + (q >> 1), kg4 = (g4 == 1) ? 2 : (g4 == 2) ? 1 : g4, j = (tg >> 1) * 16 + kg4 * 4 + (2 * q & 3);
            w[q] = (unsigned)TL[j * 136 + d] | ((unsigned)TL[(j + 1) * 136 + d] << 16); }
        *(GAS v4u*)(dst + (size_t)d * T + tt * 64 + tg * 8) = (v4u){w[0], w[1], w[2], w[3]}; }
    __syncthreads();
}
__device__ __forceinline__ void kmean_unit(const Ctx& C, const bf16* Z, int unit) {
    const int blk = unit & 31, h = (unit >> 5) & 7, b = unit >> 8;
    LAS float* PS = (LAS float*)C.lds;
    const int dg = C.tid & 15, tg = C.tid >> 4; float s[8];
#pragma unroll
    for (int q = 0; q < 8; ++q) s[q] = 0.f;
#pragma unroll
    for (int j = 0; j < 8; ++j) { const v4u kv = *(const GAS v4u*)(Z + ((size_t)b * T + blk * 256 + tg * 8 + j) * LDZ + ZD_K + h * 128 + dg * 8);
        s[0] += bflo(kv.x); s[1] += bfhi(kv.x); s[2] += bflo(kv.y); s[3] += bfhi(kv.y); s[4] += bflo(kv.z); s[5] += bfhi(kv.z); s[6] += bflo(kv.w); s[7] += bfhi(kv.w); }
    __syncthreads();
#pragma unroll
    for (int q = 0; q < 8; ++q) PS[tg * 128 + dg * 8 + q] = s[q];
    __syncthreads();
    if (C.tid < 128) { float a = 0.f;
#pragma unroll
        for (int g = 0; g < 32; ++g) a += PS[g * 128 + C.tid];
        ((bf16*)(C.ws + WS_KMEAN))[(size_t)unit * 128 + C.tid] = (bf16)f2bf(a * (1.f / 256.f)); }
    __syncthreads();
}
constexpr int A1_SC = 0, A1_HIST = 131072, A1_MSK = 147456, A1_CV = 151552, A1_CI = 152576, A1_MM = 153600, A1_NLH = 153856, A1_FLAG = 153920;
constexpr int DSA_K = 256, A1_NBIN = 1024;
__device__ __forceinline__ unsigned lane_prefix(unsigned long long m) { return __builtin_amdgcn_mbcnt_hi((unsigned)(m >> 32), __builtin_amdgcn_mbcnt_lo((unsigned)m, 0u)); }
__device__ __forceinline__ int sel_bin(float v, float lo, float scale) { const float d = v - lo; return d <= 0.f ? 1 : 1 + (int)fminf(d * scale, (float)(A1_NBIN - 2)); }
__device__ __forceinline__ int sel_bin_m(float v, int i, int n, float lo, float hi, float scale) {
    const float d = v - lo; const int x = (int)fminf(d * scale, (float)(A1_NBIN - 2)); const int bn = (d > 0.f) ? 1 + x : 1;
    const bool inr = (i < n) & (v >= lo) & (v <= hi); return inr ? bn : 0; }
#define A1_LD8(dst, base_) do { _Pragma("unroll") for (int u_ = 0; u_ < 8; ++u_) dst[u_] = s[(base_) + 64 * u_ + lane]; } while (0)
template <bool SMALL> __device__ __forceinline__ void a1_pass2_step(const float (&v8)[8], int base, int n, float lo, float hi, float scale, int bstar, int lane, LAS unsigned* msk,
                                                                    LAS float* cv, LAS unsigned* ci, int& cnt, int cdir, float& nlo, float& nhi) {
    int b8[8];
#pragma unroll
    for (int u = 0; u < 8; ++u) b8[u] = sel_bin_m(v8[u], base + 64 * u + lane, n, lo, hi, scale);
#pragma unroll
    for (int u = 0; u < 8; ++u) {
        if (b8[u] > bstar) { const int i = base + 64 * u + lane; __hip_atomic_fetch_or(msk + (i >> 5), 1u << (i & 31), __ATOMIC_RELAXED, __HIP_MEMORY_SCOPE_WORKGROUP); }
        const bool isc = b8[u] == bstar;
        if (SMALL) { const unsigned long long cb = __ballot(isc);
            if (cb) { if (isc) { const int pos = cnt + cdir * (int)lane_prefix(cb); cv[pos] = v8[u]; ci[pos] = (unsigned)(base + 64 * u + lane); } cnt += cdir * __popcll(cb); } }
        else { nlo = isc ? fminf(nlo, v8[u]) : nlo; nhi = isc ? fmaxf(nhi, v8[u]) : nhi; }
    }
}
__device__ __forceinline__ void dsa_select_block(const Ctx& C, int t0) {
    const int lane = C.lane, r = C.wave >> 1, hf = C.wave & 1, n = t0 + r + 1;
    const LAS float* s = (const LAS float*)(C.lds + A1_SC) + r * 8192;
    LAS unsigned* hist = (LAS unsigned*)(C.lds + A1_HIST) + r * A1_NBIN; LAS unsigned* msk = (LAS unsigned*)(C.lds + A1_MSK) + r * 256;
    LAS float* cv = (LAS float*)(C.lds + A1_CV) + r * 64; LAS unsigned* ci = (LAS unsigned*)(C.lds + A1_CI) + r * 64;
    LAS float* MM = (LAS float*)(C.lds + A1_MM); LAS float* NLH = (LAS float*)(C.lds + A1_NLH); volatile LAS unsigned* FL = (volatile LAS unsigned*)(C.lds + A1_FLAG);
    const float PINF = __builtin_inff();
    float lo = MM[r * 2], hi = MM[r * 2 + 1];
#pragma unroll
    for (int w = 1; w < NWAVES; ++w) { lo = fminf(lo, MM[(w * 4 + r) * 2]); hi = fmaxf(hi, MM[(w * 4 + r) * 2 + 1]); }
    bool active = n > DSA_K; bool dorank = false;
    int need = DSA_K, ncand = 0;
    *(LAS v2u*)(msk + hf * 128 + 2 * lane) = (v2u){0u, 0u};
    if (C.tid < 2) FL[C.tid] = 0u;
    const int nstep = (n + 511) >> 9;
    for (int iter = 0; iter < 64; ++iter) {
        __syncthreads();
        if (active && lane == 0) FL[iter & 1] = 1u;
        __syncthreads();
        const bool any = FL[iter & 1] != 0u;
        if (C.tid == 0) FL[(iter + 1) & 1] = 0u;
        if (!any) break;
        if (active && lo == hi) {
            if (hf == 0) { int running = 0;
                for (int base = 0; base < n && running < need; base += 64) { const int i = base + lane; const bool cnd = (i < n) && (s[i] == lo);
                    const unsigned long long bal = __ballot(cnd); const bool sel = cnd && (running + (int)lane_prefix(bal) < need);
                    if (sel) __hip_atomic_fetch_or(msk + (i >> 5), 1u << (i & 31), __ATOMIC_RELAXED, __HIP_MEMORY_SCOPE_WORKGROUP);
                    running += __popcll(bal); } }
            need = 0; active = false;
        }
        if (active) {
#pragma unroll
            for (int q = 0; q < 2; ++q) *(LAS v4u*)(hist + hf * 512 + 256 * q + 4 * lane) = (v4u){0u, 0u, 0u, 0u}; }
        __syncthreads();
        const float scale = (float)(A1_NBIN - 1) / (hi - lo);
        if (active) { float v8[8]; A1_LD8(v8, hf * 512);
            for (int st = hf; st < nstep; st += 2) { const int base = st * 512;
                float nx[8]; A1_LD8(nx, (st + 2 < nstep ? st + 2 : st) * 512);
#pragma unroll
                for (int u = 0; u < 8; ++u) asm volatile("" : "+v"(v8[u]));
#pragma unroll
                for (int u = 0; u < 8; ++u) { const int bn = sel_bin_m(v8[u], base + 64 * u + lane, n, lo, hi, scale);
                    __hip_atomic_fetch_add(hist + bn, 1u, __ATOMIC_RELAXED, __HIP_MEMORY_SCOPE_WORKGROUP); }
#pragma unroll
                for (int u = 0; u < 8; ++u) v8[u] = nx[u]; } }
        __syncthreads();
        int bstar = 1, cabove = 0, mcnt = 0; float nlo = PINF, nhi = -PINF;
        if (active) {
            unsigned hb[16]; unsigned mysum = 0;
#pragma unroll
            for (int q = 0; q < 4; ++q) { const v4u h4 = *(const LAS v4u*)(hist + lane * 16 + q * 4); hb[4 * q] = h4.x; hb[4 * q + 1] = h4.y; hb[4 * q + 2] = h4.z; hb[4 * q + 3] = h4.w; mysum += h4.x + h4.y + h4.z + h4.w; }
            if (lane == 0) mysum -= hb[0];
            unsigned suf = mysum;
#pragma unroll
            for (int o = 1; o < 64; o <<= 1) { const unsigned nb = __shfl_down(suf, o); if (lane + o < 64) suf += nb; }
            const unsigned long long okm = __ballot(suf >= (unsigned)need);
            const int L = okm ? 63 - __builtin_clzll(okm) : 0;
            if (lane == L) { unsigned a = suf - mysum;
#pragma unroll
                for (int q = 15; q >= 0; --q) { if (mcnt == 0 && (lane > 0 || q > 0)) { if (a + hb[q] >= (unsigned)need) { bstar = lane * 16 + q; cabove = (int)a; mcnt = (int)hb[q]; } else a += hb[q]; } } }
            bstar = __shfl(bstar, L); cabove = __shfl(cabove, L); mcnt = __shfl(mcnt, L);
            int cnt = hf ? mcnt - 1 : 0; const int cdir = hf ? -1 : 1;
            float v8[8]; A1_LD8(v8, hf * 512);
            for (int st = hf; st < nstep; st += 2) { const int base = st * 512;
                float nx[8]; A1_LD8(nx, (st + 2 < nstep ? st + 2 : st) * 512);
#pragma unroll
                for (int u = 0; u < 8; ++u) asm volatile("" : "+v"(v8[u]));
                if (mcnt <= 64) a1_pass2_step<true>(v8, base, n, lo, hi, scale, bstar, lane, msk, cv, ci, cnt, cdir, nlo, nhi); else a1_pass2_step<false>(v8, base, n, lo, hi, scale, bstar, lane, msk, cv, ci, cnt, cdir, nlo, nhi);
#pragma unroll
                for (int u = 0; u < 8; ++u) v8[u] = nx[u]; }
            if (mcnt > 64) { nlo = wave_min(nlo); nhi = wave_max(nhi); if (lane == 0) { NLH[C.wave * 2] = nlo; NLH[C.wave * 2 + 1] = nhi; } }
        }
        __syncthreads();
        if (active) { need -= cabove;
            if (mcnt <= 64) { ncand = mcnt; dorank = true; active = false; }
            else { lo = fminf(NLH[4 * r], NLH[4 * r + 2]); hi = fmaxf(NLH[4 * r + 1], NLH[4 * r + 3]); } }
    }
    __syncthreads();
    if (hf == 0) {
        if (n <= DSA_K) { for (int w = lane; w < 256; w += 64) { const int rem = n - 32 * w; msk[w] = rem >= 32 ? 0xffffffffu : rem > 0 ? ((1u << rem) - 1u) : 0u; } }
        else if (dorank && ncand > 0) {
            const float vj = (lane < ncand) ? cv[lane] : 0.f; const unsigned ij = (lane < ncand) ? ci[lane] : 0u; int rank = 0;
            for (int k = 0; k < ncand; ++k) { const float vk = cv[k]; const unsigned ik = ci[k]; rank += (vk > vj || (vk == vj && ik < ij)) ? 1 : 0; }
            if (lane < ncand && rank < need) __hip_atomic_fetch_or(msk + (ij >> 5), 1u << (ij & 31), __ATOMIC_RELAXED, __HIP_MEMORY_SCOPE_WORKGROUP);
        }
    }
}
__device__ __forceinline__ void dsa_a1_unit(const Ctx& C, const bf16* Z, int unit, int pflags = 0) {
    const int b = unit >> 11, t0 = (2047 - (unit & 2047)) * 4;
    LAS float* SC = (LAS float*)(C.lds + A1_SC); LAS float* MM = (LAS float*)(C.lds + A1_MM);
    const int nk = t0 + 4, ntile = (nk + 15) >> 4;
    const int row = C.lane & 15, kg = C.lane >> 4;
    bf16x8 af[4];
    { const bf16* qp = Z + ((size_t)b * T + t0 + (row >> 2)) * LDZ + ZA_IQ + (row & 3) * 128 + kg * 8;
#pragma unroll
      for (int ks = 0; ks < 4; ++ks) af[ks] = *(const GAS bf16x8*)(qp + ks * 32); }
    float wv[4];
    { const bf16* wp = Z + ((size_t)b * T + t0 + kg) * LDZ + ZS_IW;
#pragma unroll
      for (int r = 0; r < 4; ++r) wv[r] = bf2f(wp[r]); }
    const bf16* IKb = (const bf16*)(C.ws + WS_IK) + (size_t)b * T * 128 + C.lane * 8;
    float lmin = __builtin_inff(), lmax = -__builtin_inff(); const int qn = t0 + kg;
    __syncthreads();
    if (!(pflags & 2)) for (int kt0 = C.wave; kt0 < ntile; kt0 += 8 * NWAVES) {
        bf16x8 bfr[8][4];
#pragma unroll
        for (int j = 0; j < 8; ++j) { int kt = kt0 + j * NWAVES; kt = kt < ntile ? kt : ntile - 1;
#pragma unroll
            for (int ks = 0; ks < 4; ++ks) bfr[j][ks] = *(const GAS bf16x8*)(IKb + (size_t)kt * 2048 + ks * 512); }
#pragma unroll
        for (int j = 0; j < 8; ++j) { const int kt = kt0 + j * NWAVES;
            f32x4 acc = (f32x4){0.f, 0.f, 0.f, 0.f};
#pragma unroll
            for (int ks = 0; ks < 4; ++ks) acc = MFMA16(af[ks], bfr[j][ks], acc);
            const float sc = wv[0] * fmaxf(acc[0], 0.f) + wv[1] * fmaxf(acc[1], 0.f) + wv[2] * fmaxf(acc[2], 0.f) + wv[3] * fmaxf(acc[3], 0.f);
            if (kt < ntile) SC[kg * 8192 + kt * 16 + row] = sc;
            const bool vld = kt * 16 + row <= qn;
            lmin = vld ? fminf(lmin, sc) : lmin; lmax = vld ? fmaxf(lmax, sc) : lmax; }
    }
#pragma unroll
    for (int o = 1; o < 16; o <<= 1) { lmin = fminf(lmin, __shfl_xor(lmin, o)); lmax = fmaxf(lmax, __shfl_xor(lmax, o)); }
    if (row == 0) { MM[(C.wave * 4 + kg) * 2] = lmin; MM[(C.wave * 4 + kg) * 2 + 1] = lmax; }
    __syncthreads();
    if (!(pflags & 1)) dsa_select_block(C, t0);
    __syncthreads();
    if (C.tid < 256 && pflags == 0) { const LAS unsigned* MK = (const LAS unsigned*)(C.lds + A1_MSK);
        *(GAS v4u*)((unsigned*)(C.ws + WS_MASK) + ((size_t)b * 256 + C.tid) * T + t0) = (v4u){MK[C.tid], MK[256 + C.tid], MK[512 + C.tid], MK[768 + C.tid]}; }
}
#undef A1_LD8
constexpr int AT_KT = 0, AT_VT = 17408, AT_STAGE = 35840, AT_UNION = 2 * AT_STAGE;
template <int MODE>
__device__ __forceinline__ void attn_unit(const Ctx& C, const bf16* Z, bf16* MIX, int unit) {
    const int qt = 31 - (unit & 31), h = (unit >> 5) & 7, b = unit >> 8;
    int lane_o = C.lane, tid_o = C.tid; asm volatile("" : "+v"(lane_o), "+v"(tid_o));
    const int q0 = qt * 256; const int col = lane_o & 31, hh = lane_o >> 5;
    const int tq = q0 + C.wave * 32 + col;
    const size_t mq = (size_t)b * T + tq;
    const int zq = (MODE == 0 ? ZA_Q : ZD_Q) + h * 128, zk = (MODE == 0 ? ZA_K + (h >> 2) * 128 : ZD_K + h * 128);
    const bf16* VTg = (MODE == 0) ? (const bf16*)(C.ws + WS_VTA) + ((size_t)(b * 2 + (h >> 2)) * 128) * T : (const bf16*)(C.ws + WS_VTD) + ((size_t)(b * 8 + h) * 128) * T;
    bf16x8 Qf[8];
#pragma unroll
    for (int ks = 0; ks < 8; ++ks) Qf[ks] = *(const GAS bf16x8*)(Z + mq * LDZ + zq + ks * 16 + hh * 8);
    unsigned selmask = 0u; unsigned uni = 0xffffffffu;
    __syncthreads();
    if (MODE == 1) {
        LAS unsigned* UN = (LAS unsigned*)(C.lds + AT_UNION);
        if (C.tid == 0) *UN = 0u;
        const bf16* KM = (const bf16*)(C.ws + WS_KMEAN) + ((size_t)(b * 8 + h) * 32) * 128;
        f32x16 g;
#pragma unroll
        for (int r = 0; r < 16; ++r) g[r] = 0.f;
#pragma unroll
        for (int ks = 0; ks < 8; ++ks) g = MFMA32(*(const GAS bf16x8*)(KM + (size_t)col * 128 + ks * 16 + hh * 8), Qf[ks], g);
        const int nsel = qt < 3 ? qt : 3;
        for (int it = 0; it < nsel; ++it) { float bv = -__builtin_inff(); int bi = 64;
#pragma unroll
            for (int r = 0; r < 16; ++r) { const int blk = (r & 3) + 8 * (r >> 2) + 4 * hh; const bool ok = blk < qt && !((selmask >> blk) & 1u);
                if (ok && (g[r] > bv || (g[r] == bv && blk < bi))) { bv = g[r]; bi = blk; } }
            const float ov = __shfl_xor(bv, 32); const int oi = __shfl_xor(bi, 32);
            if (ov > bv || (ov == bv && oi < bi)) { bv = ov; bi = oi; }
            if (bi < 32) selmask |= 1u << bi; }
        unsigned um = selmask;
#pragma unroll
        for (int o = 1; o < 32; o <<= 1) um |= __shfl_xor(um, o);
        __syncthreads();
        if (C.lane == 0) __hip_atomic_fetch_or(UN, um, __ATOMIC_RELAXED, __HIP_MEMORY_SCOPE_WORKGROUP);
        __syncthreads();
        uni = *UN | (1u << qt);
    }
    const unsigned* MK = (const unsigned*)(C.ws + WS_MASK) + (size_t)b * 256 * T + tq;
    f32x16 O[4];
#pragma unroll
    for (int dt = 0; dt < 4; ++dt)
#pragma unroll
        for (int r = 0; r < 16; ++r) O[dt][r] = 0.f;
    float mrun = -1e30f, lrun = 0.f;
    const float SCL = 0.08838834764831845f * 1.4426950408889634f;
    const int ntile = 4 * (qt + 1);
    v4u kreg[2], vreg[2];
#define ldtile(KT_) do { _Pragma("unroll") for (int i_ = 0; i_ < 2; ++i_) { const int e_ = tid_o + i_ * NTHREADS; \
            kreg[i_] = *(const GAS v4u*)(Z + ((size_t)b * T + (KT_) * 64 + (e_ >> 4)) * LDZ + zk + (e_ & 15) * 8); \
            vreg[i_] = *(const GAS v4u*)(VTg + (size_t)(e_ >> 3) * T + (KT_) * 64 + (e_ & 7) * 8); } } while (0)
#define sttile(ST_) do { _Pragma("unroll") for (int i_ = 0; i_ < 2; ++i_) { const int e_ = tid_o + i_ * NTHREADS; \
            *(LAS v4u*)(C.lds + (ST_) * AT_STAGE + AT_KT + ((e_ >> 4) * 136 + (e_ & 15) * 8) * 2) = kreg[i_]; \
            *(LAS v4u*)(C.lds + (ST_) * AT_STAGE + AT_VT + ((e_ >> 3) * 72 + (e_ & 7) * 8) * 2) = vreg[i_]; } } while (0)
    int kt = 0;
    while (kt < ntile && !((uni >> (kt >> 2)) & 1u)) ++kt;
    unsigned mwn[2] = {0xffffffffu, 0xffffffffu};
    if (kt < ntile) { if (MODE == 0) { mwn[0] = MK[(size_t)(kt * 2) * T]; mwn[1] = MK[(size_t)(kt * 2 + 1) * T]; } ldtile(kt); sttile(0); }
    __syncthreads();
    int st = 0;
    while (kt < ntile) {
        int kn = kt + 1;
        while (kn < ntile && !((uni >> (kn >> 2)) & 1u)) ++kn;
        const unsigned mw[2] = {mwn[0], mwn[1]};
        if (kn < ntile) { if (MODE == 0) { mwn[0] = MK[(size_t)(kn * 2) * T]; mwn[1] = MK[(size_t)(kn * 2 + 1) * T]; } ldtile(kn); }
        const LAS bf16* Ks = (const LAS bf16*)(C.lds + st * AT_STAGE + AT_KT); const LAS bf16* Vs = (const LAS bf16*)(C.lds + st * AT_STAGE + AT_VT);
        f32x16 S2[2];
#pragma unroll
        for (int kk = 0; kk < 2; ++kk) {
#pragma unroll
            for (int r = 0; r < 16; ++r) S2[kk][r] = 0.f;
#pragma unroll
            for (int ks = 0; ks < 8; ++ks) S2[kk] = MFMA32(*(const LAS bf16x8*)(Ks + (kk * 32 + col) * 136 + ks * 16 + hh * 8), Qf[ks], S2[kk]);
            asm volatile("" ::: "memory");
        }
        float mloc = -__builtin_inff();
        const int blk = kt >> 2;
#pragma unroll
        for (int kk = 0; kk < 2; ++kk)
#pragma unroll
            for (int r = 0; r < 16; ++r) { const int kin = (r & 3) + 8 * (r >> 2) + 4 * hh;
                bool ok;
                if (MODE == 0) ok = (mw[kk] >> kin) & 1u;
                else ok = (blk == qt) ? (kt * 64 + kk * 32 + kin <= tq) : ((selmask >> blk) & 1u);
                const float v = ok ? S2[kk][r] : -__builtin_inff(); S2[kk][r] = v; mloc = fmaxf(mloc, v); }
        mloc = fmaxf(mloc, __shfl_xor(mloc, 32)) * SCL;
        const float mnew = fmaxf(mrun, mloc); const float alpha = exp2f(mrun - mnew); mrun = mnew;
        float ls = 0.f;
#pragma unroll
        for (int kk = 0; kk < 2; ++kk)
#pragma unroll
            for (int r = 0; r < 16; ++r) { const float p = exp2f(__builtin_fmaf(S2[kk][r], SCL, -mnew)); S2[kk][r] = p; ls += p; }
        lrun = lrun * alpha + ls;
        if (__any(alpha != 1.f)) {
#pragma unroll
            for (int dt = 0; dt < 4; ++dt)
#pragma unroll
                for (int r = 0; r < 16; ++r) O[dt][r] *= alpha; }
        bf16x8 Pb[2][2];
#pragma unroll
        for (int kk = 0; kk < 2; ++kk)
#pragma unroll
            for (int s = 0; s < 2; ++s) Pb[kk][s] = __builtin_bit_cast(bf16x8, pack8(S2[kk], s));
#pragma unroll
        for (int dt = 0; dt < 4; ++dt)
#pragma unroll
            for (int kk = 0; kk < 2; ++kk)
#pragma unroll
                for (int s = 0; s < 2; ++s) {
                    O[dt] = MFMA32(*(const LAS bf16x8*)(Vs + (dt * 32 + col) * 72 + kk * 32 + s * 16 + hh * 8), Pb[kk][s], O[dt]); if (kk == 1 && s == 1 && (dt & 1)) asm volatile("" ::: "memory"); }
        if (kn < ntile) sttile(st ^ 1);
        __syncthreads();
        st ^= 1; kt = kn;
    }
    const float l = lrun + __shfl_xor(lrun, 32); const float il = 1.f / l;
    bf16* op = MIX + mq * D + (MODE == 0 ? MX_A : MX_D) + h * 128 + 4 * hh;
#pragma unroll
    for (int dt = 0; dt < 4; ++dt)
#pragma unroll
        for (int q = 0; q < 4; ++q) { v2u w; w.x = pk2(O[dt][4 * q] * il, O[dt][4 * q + 1] * il); w.y = pk2(O[dt][4 * q + 2] * il, O[dt][4 * q + 3] * il);
            *(GAS v2u*)(op + dt * 32 + 8 * q) = w; }
#undef ldtile
#undef sttile
    __syncthreads();
}
constexpr int SUB_A1 = 1, SUB_C1 = 2, SUB_B1 = 4, SUB_KM = 8, SUB_C2 = 16, SUB_AT0 = 32, SUB_AT1 = 64, SUB_B2 = 128, SUB_ALL = 255, SUB_DUMMY = 256;
constexpr int N_PHASES = 1 + 10 * NLAYER;
#define IN(k) (lo <= (k) && (k) < hi)
#define SEAM(k) do { if (IN(k) && IN((k) + 1)) xcd_barrier(bar); } while (0)
template <int l> __device__ __forceinline__ void layer_body(const Ctx& C, const Args& args, const int lo, const int hi, const XcdBarrier& bar, gu32* ctl) {
    bf16* HB = (bf16*)(C.ws + WS_HB); bf16* Z = (bf16*)(C.ws + WS_Z); bf16* MIX = (bf16*)(C.ws + WS_MIX); bf16* FF = (bf16*)(C.ws + WS_FF);
    const bool dummy = (args.sub & SUB_DUMMY) != 0;
    const int pb = 1 + 10 * l;
    constexpr int NT_MAIN = 48, TAIL_WGS = M / 256;
    if (IN(pb + 0)) {
        pg8::Gemm g{HB, (const bf16*)(C.ws + WS_WIN + l * WIN_BYTES), M, LDZ, D}; pg8::StaticOrder S; S.init(M, (C.G > TAIL_WGS ? NT_MAIN : NT_MAIN + 1) * 256, C.G, C.bid);
        pg8::EpiStoreBf16 E{Z, LDZ};
        pg8::gemm_phase<pg8::EpiStoreBf16, pg8::StaticOrder, true, true>(C.lds, g, S, E);
    } SEAM(pb + 0);
    if (IN(pb + 1)) {
        if (C.bid < TAIL_WGS && C.G > TAIL_WGS) {
            pg8::Gemm g{HB, (const bf16*)(C.ws + WS_WIN + l * WIN_BYTES), M, LDZ, D}; pg8::ColumnOrder S{C.bid, TAIL_WGS, NT_MAIN};
            pg8::EpiStoreBf16 E{Z, LDZ};
            pg8::gemm_phase<pg8::EpiStoreBf16, pg8::ColumnOrder, true, true>(C.lds, g, S, E);
        } else {
            const int w0 = C.G > TAIL_WGS ? TAIL_WGS : 0, nw = C.G - w0;
            rope_phase(C, Z, dummy ? (long)((WS_SCR - WS_Z) / 2) : 0L, dummy ? (long)((WS_SCR + 400 * MiB - WS_IK) / 2) : 0L, w0, nw);
            for (int u = C.bid - w0; u < 2 * 10 * 128; u += nw) if ((u >> 7) % 10 != 9) vt_unit(C, Z, u);
        }
    } SEAM(pb + 1);
    if (IN(pb + 2)) {
        const float* w2 = args.in[7] + (size_t)l * 16 * 512; const float* gb = args.in[8] + (size_t)l * 512;
        const float* convw = args.in[10] + (size_t)l * 4 * 3072; const float* alog = args.in[11] + (size_t)l * 8; const float* dtb = args.in[12] + (size_t)l * 8;
        if (args.sub & SUB_KM) for (int u = C.bid; u < 256; u += C.G) vt_unit(C, Z, (u >> 7) * 1280 + 9 * 128 + (u & 127));
        if (args.sub & SUB_A1) { const bool serp = (4096 % C.G) == 0;
            for (int k = 0; k * C.G < 4096; ++k) { const int u = k * C.G + ((serp && (k & 1)) ? C.G - 1 - C.bid : C.bid); if (u < 4096) dsa_a1_unit(C, Z, u, (args.sub >> 9) & 3); } }
        if (args.sub & SUB_C1) for (int u = C.bid; u < 2048; u += C.G) gdn_c1_unit(C, Z, convw, alog, dtb, u);
        if (args.sub & SUB_B1) for (int u = C.bid; u < 1024; u += C.G) gla_b1_unit(C, Z, w2, gb, u);
        if (args.sub & SUB_KM) for (int u = C.bid; u < 512; u += C.G) kmean_unit(C, Z, u);
    } SEAM(pb + 2);
    if (IN(pb + 3)) {
        gu32* head = ctl + CW_QUEUE + 64 * 4 * l + 1024 * args.qrep;
        if (args.sub & SUB_C2) for (;;) { const int u = q_next(C, head); if (u >= 16) break; if (C.wave < 4) gdn_c2_wave(C, u, C.wave, (float*)(C.ws + WS_GDN_O)); }
        if (args.sub & SUB_B2) for (;;) { const int u = q_next(C, head + 192); if (u >= 128) break; gla_b2_unit(C, u); }
        if (args.sub & SUB_AT0) for (;;) { const int u = q_next(C, head + 64); if (u >= 512) break; attn_unit<0>(C, Z, MIX, (((u >> 3) & 1) << 8) | ((u & 7) << 5) | (u >> 4)); }
        if (args.sub & SUB_AT1) for (;;) { const int u = q_next(C, head + 128); if (u >= 512) break; attn_unit<1>(C, Z, MIX, (((u >> 3) & 1) << 8) | ((u & 7) << 5) | (u >> 4)); }
    } SEAM(pb + 3);
    if (IN(pb + 4)) {
        const float* w2 = args.in[7] + (size_t)l * 16 * 512; const float* gb = args.in[8] + (size_t)l * 512;
        for (int u = C.bid; u < 1024; u += C.G) gla_b3_unit(C, Z, MIX, w2, gb, args.in[9] + (size_t)l * 256, u);
        gdn_c3(C, Z, MIX, args.in[13] + (size_t)l * 128);
    } SEAM(pb + 4);
    float* const pdst = (float*)(C.ws + WS_SCR); bf16* const pdstb = (bf16*)(C.ws + WS_SCR + (size_t)M * D * 4); float* const pstat = (float*)(C.ws + WS_SCR + (size_t)M * D * 6);
    float* const stats = (float*)(C.ws + WS_STATS);
    if (IN(pb + 5)) {
        pg8::Gemm g{MIX, (const bf16*)(C.ws + WS_WOUT + l * WOUT_BYTES), M, D, D}; pg8::StaticOrder S; S.init(M, D, C.G, C.bid);
        pg8::EpiResidual E{l == 0 ? args.in[0] : C.out, dummy ? pdst : C.out, D, DN_ALPHA, stats, l == 0 ? args.in[1] : args.in[16] + (size_t)(l - 1) * D, l == 0 ? args.in[2] : args.in[17] + (size_t)(l - 1) * D};
        pg8::gemm_phase<pg8::EpiResidual, pg8::StaticOrder, true, true>(C.lds, g, S, E);
    } SEAM(pb + 5);
    if (IN(pb + 6)) { ln_phase(C, C.out, nullptr, dummy ? pdstb : HB, dummy ? pstat : stats, args.in[5] + (size_t)l * D, args.in[6] + (size_t)l * D); } SEAM(pb + 6);
    if (IN(pb + 7)) {
        pg8::Gemm g{HB, (const bf16*)(C.ws + WS_WUP + l * WUP_BYTES), M, DFF, D}; pg8::StaticOrder S; S.init(M, DFF, C.G, C.bid);
        pg8::EpiSqRelu E{FF, DFF};
        pg8::gemm_phase<pg8::EpiSqRelu, pg8::StaticOrder, true, true>(C.lds, g, S, E);
    } SEAM(pb + 7);
    if (IN(pb + 8)) {
        pg8::Gemm g{FF, (const bf16*)(C.ws + WS_WDN + l * WDN_BYTES), M, D, DFF}; pg8::StaticOrder S; S.init(M, D, C.G, C.bid);
        pg8::EpiResidual E{C.out, dummy ? pdst : C.out, D, DN_ALPHA, stats, args.in[5] + (size_t)l * D, args.in[6] + (size_t)l * D};
        pg8::gemm_phase<pg8::EpiResidual, pg8::StaticOrder, true, true>(C.lds, g, S, E);
    } SEAM(pb + 8);
    if (IN(pb + 9)) {
        if (l + 1 < NLAYER) ln_phase(C, C.out, nullptr, dummy ? pdstb : HB, dummy ? pstat : stats, args.in[16] + (size_t)l * D, args.in[17] + (size_t)l * D);
        else ln_phase(C, C.out, dummy ? pdst : C.out, nullptr, nullptr, args.in[16] + (size_t)l * D, args.in[17] + (size_t)l * D);
    }
    if (l + 1 < NLAYER) SEAM(pb + 9);
}
__global__ void __launch_bounds__(NTHREADS, 2) mk_fwd(Args args_byval) {
    const Args& args = *(const Args*)__builtin_amdgcn_kernarg_segment_ptr();
    extern __shared__ __attribute__((aligned(16))) unsigned char lds_raw[];
    Ctx C; C.lds = (LAS unsigned char*)lds_raw; C.tid = threadIdx.x; C.lane = C.tid & 63; C.wave = __builtin_amdgcn_readfirstlane(C.tid >> 6);
    C.bid = blockIdx.x; C.G = gridDim.x; C.ws = args.ws; C.out = args.out;
    gu32* ctl = (gu32*)(C.ws + WS_CTL);
    volatile LAS unsigned* MISC = (volatile LAS unsigned*)(C.lds + MISC_OFF);
    if (C.tid < 64) MISC[C.tid] = 0u;
    __syncthreads();
    const int lo = args.ph_lo, hi = args.ph_hi;
    const bool multi = (hi - lo) > 1;
    XcdBarrier bar; bar.bar = (unsigned*)(ctl + CW_BAR); bar.x = 0; bar.st = nullptr;
    if (multi) bar = xcd_barrier_post((unsigned*)(ctl + CW_BAR), MISC);

    if (IN(0)) init_phase(C, args);
    SEAM(0);
    layer_body<0>(C, args, lo, hi, bar, ctl);
    layer_body<1>(C, args, lo, hi, bar, ctl);
}
#undef IN
#undef SEAM

#ifndef MK_MULTI_LAUNCH
#define MK_MULTI_LAUNCH 0
#endif
#ifndef PROBE_REP_MASK
#define PROBE_REP_MASK 0u
#endif
#ifndef PROBE_SUB
#define PROBE_SUB SUB_ALL
#endif
extern "C" void kernel_launch(void* const* d_in, const int* in_sizes, int n_in, void* d_out, int out_size, void* d_ws, size_t ws_size, hipStream_t stream) {
    static int grid = 0;
    if (grid == 0) {
        if (n_in != 18 || out_size != M * D || ws_size < WS_END) { fprintf(stderr, "kernel_launch: unexpected shapes: n_in %d out %d ws %zu (need %zu)\n", n_in, out_size, ws_size, (size_t)WS_END); grid = -1; return; }
        int dev = 0, cus = 0, per_cu = 0;
        if (hipGetDevice(&dev) != hipSuccess || hipDeviceGetAttribute(&cus, hipDeviceAttributeMultiprocessorCount, dev) != hipSuccess) { grid = -1; return; }
        if (hipFuncSetAttribute((const void*)mk_fwd, hipFuncAttributeMaxDynamicSharedMemorySize, LDS_BYTES) != hipSuccess) { fprintf(stderr, "kernel_launch: hipFuncSetAttribute failed\n"); grid = -1; return; }
        if (hipOccupancyMaxActiveBlocksPerMultiprocessor(&per_cu, (const void*)mk_fwd, NTHREADS, LDS_BYTES) != hipSuccess || per_cu < 1) fprintf(stderr, "kernel_launch: occupancy query says %d\n", per_cu);
        (void)hipGetLastError();
        grid = cus;
    }
    if (grid < 0) return;
    (void)hipMemsetAsync((char*)d_ws + WS_CTL, 0, CTL_ZERO_BYTES, stream);
    Args a{};
    for (int i = 0; i < 18; ++i) a.in[i] = (const float*)d_in[i];
    a.out = (float*)d_out; a.ws = (unsigned char*)d_ws;
#if MK_MULTI_LAUNCH
    for (int ph = 0; ph < N_PHASES; ++ph) { a.ph_lo = ph; a.ph_hi = ph + 1;
        for (int rep = 0; rep < 1 + (int)((PROBE_REP_MASK >> ph) & 1u); ++rep) { a.sub = rep ? (PROBE_SUB) : SUB_ALL; a.qrep = rep; hipLaunchKernelGGL(mk_fwd, dim3(grid), dim3(NTHREADS), LDS_BYTES, stream, a); } }
#else
    a.ph_lo = 0; a.ph_hi = N_PHASES; a.sub = SUB_ALL; a.qrep = 0; hipLaunchKernelGGL(mk_fwd, dim3(grid), dim3(NTHREADS), LDS_BYTES, stream, a);
#endif
}
```

```cpp
#include <hip/hip_runtime.h>
#include <cstdio>
#include <cstdint>
namespace pg8 {
#define PG8_LAS __attribute__((address_space(3)))
typedef unsigned short bf16_t;
typedef short bf16x8 __attribute__((ext_vector_type(8)));
typedef float f32x4 __attribute__((ext_vector_type(4)));
typedef unsigned u32x4 __attribute__((ext_vector_type(4)));
constexpr int BM = 256, BK = 64, HALF = 128, HTB = HALF * BK * 2  , STAGE_BYTES = 8 * HTB, NXCD = 8, WGM = 8;

__host__ __device__ __forceinline__ int lds_byte(int r, int c) { const int st = (r >> 4) * 2 + (c >> 5), rr = r & 15, cc = c & 31, ob = rr * 64 + cc * 2; return st * 1024 + (ob ^ (((ob >> 9) & 1) << 5)); }
__host__ __device__ __forceinline__ void stage_rc(int b, int& R, int& C) { const int st = b / 1024, sb = b % 1024, swz = sb ^ (((sb >> 9) & 1) << 5); R = (st >> 1) * 16 + swz / 64; C = (st & 1) * 32 + (swz % 64) / 2; }
__host__ __device__ __forceinline__ int perm32(int rho) { const int n = rho >> 4, i = rho & 15; return 8 * (i >> 2) + 4 * n + (i & 3); }

struct Unit { int pm, pn; };
struct Gemm { const bf16_t* A; const bf16_t* Bt; int M, N, K; };

struct StaticOrder {
    int nM, nN, nwg, G, c;
    __host__ __device__ void init(int M, int N, int G_, int c_) { nM = M / BM; nN = N / BM; nwg = nM * nN; G = G_; c = c_; }
    __host__ __device__ bool next(int i, Unit& u) const {
        const long L = (long)i * G + c; if (L >= nwg) return false;
        int wgid = (int)L; { const int q = nwg / NXCD, r = nwg % NXCD, xcd = wgid % NXCD, off = wgid / NXCD; wgid = (xcd < r ? xcd * (q + 1) : r * (q + 1) + (xcd - r) * q) + off; }
        const int nig = WGM * nN, gid = wgid / nig, fm = gid * WGM, gsz = (nM - fm) < WGM ? (nM - fm) : WGM;
        u.pm = fm + ((wgid % nig) % gsz); u.pn = (wgid % nig) / gsz; return true;
    }
    __device__ __forceinline__ void a_ready(const Unit&) const {}
    __device__ __forceinline__ void done(const Unit&) const {}
};
struct ColumnOrder {
    int c, nM, pn;
    __host__ __device__ bool next(int i, Unit& u) const { if (i > 0 || c >= nM) return false; u.pm = c; u.pn = pn; return true; }
    __device__ __forceinline__ void a_ready(const Unit&) const {}
    __device__ __forceinline__ void done(const Unit&) const {}
};
__device__ __forceinline__ unsigned cvt_pk_bf16(float lo, float hi) { unsigned r; asm volatile("v_cvt_pk_bf16_f32 %0, %1, %2" : "=v"(r) : "v"(lo), "v"(hi)); return r; }
struct EpiStoreBf16 {
    static constexpr bool PERM = true, AFTER_DRAIN = false;
    bf16_t* O; int ldc;
    __device__ __forceinline__ void operator()(const f32x4 (&acc)[2][2][4][2], const Unit& u, int wr, int wc, int fr, int fq) const {
        const int row0 = u.pm * BM + wr * 64 + fr; const int col0 = u.pn * BM + wc * 32 + 8 * fq;
#pragma unroll
        for (int ai = 0; ai < 2; ++ai)
#pragma unroll
            for (int m = 0; m < 4; ++m) { bf16_t* rowp = O + (size_t)(row0 + ai * HALF + m * 16) * ldc + col0;
#pragma unroll
                for (int bj = 0; bj < 2; ++bj) { const f32x4 v0 = acc[ai][bj][m][0], v1 = acc[ai][bj][m][1];
                    u32x4 w; w.x = cvt_pk_bf16(v0[0], v0[1]); w.y = cvt_pk_bf16(v0[2], v0[3]); w.z = cvt_pk_bf16(v1[0], v1[1]); w.w = cvt_pk_bf16(v1[2], v1[3]);
                    *(u32x4*)(rowp + bj * HALF) = w; } }
    }
};
struct EpiSqRelu {
    static constexpr bool PERM = true, AFTER_DRAIN = false;
    bf16_t* O; int ldc;
    __device__ __forceinline__ void operator()(const f32x4 (&acc)[2][2][4][2], const Unit& u, int wr, int wc, int fr, int fq) const {
        const int row0 = u.pm * BM + wr * 64 + fr; const int col0 = u.pn * BM + wc * 32 + 8 * fq;
#pragma unroll
        for (int ai = 0; ai < 2; ++ai)
#pragma unroll
            for (int m = 0; m < 4; ++m) { bf16_t* rowp = O + (size_t)(row0 + ai * HALF + m * 16) * ldc + col0;
#pragma unroll
                for (int bj = 0; bj < 2; ++bj) { f32x4 v0 = acc[ai][bj][m][0], v1 = acc[ai][bj][m][1];
#pragma unroll
                    for (int j = 0; j < 4; ++j) { const float a = fmaxf(v0[j], 0.f), b = fmaxf(v1[j], 0.f); v0[j] = a * a; v1[j] = b * b; }
                    u32x4 w; w.x = cvt_pk_bf16(v0[0], v0[1]); w.y = cvt_pk_bf16(v0[2], v0[3]); w.z = cvt_pk_bf16(v1[0], v1[1]); w.w = cvt_pk_bf16(v1[2], v1[3]);
                    *(u32x4*)(rowp + bj * HALF) = w; } }
    }
};
struct EpiResidual {
    static constexpr bool PERM = false, AFTER_DRAIN = false;
    const float* Cs; float* Cd; int ldc; float alpha; const float* st; const float* g; const float* b;
    __device__ __forceinline__ void operator()(const f32x4 (&acc)[2][2][4][2], const Unit& u, int wr, int wc, int fr, int fq) const {
        const int row0 = u.pm * BM + wr * 64 + fr, col0 = u.pn * BM + wc * 32 + 4 * fq;
        f32x4 g4[2][2], b4[2][2];
#pragma unroll
        for (int bj = 0; bj < 2; ++bj)
#pragma unroll
            for (int n = 0; n < 2; ++n) { g4[bj][n] = *(const f32x4*)(g + col0 + bj * HALF + n * 16); b4[bj][n] = *(const f32x4*)(b + col0 + bj * HALF + n * 16); }
#pragma unroll
        for (int ai = 0; ai < 2; ++ai)
#pragma unroll
            for (int m = 0; m < 4; ++m) { const int row = row0 + ai * HALF + m * 16; const size_t ro = (size_t)row * ldc + col0;
                const float mean = st[2 * row], rstd = st[2 * row + 1];
#pragma unroll
                for (int bj = 0; bj < 2; ++bj)
#pragma unroll
                    for (int n = 0; n < 2; ++n) { const f32x4 x = *(const f32x4*)(Cs + ro + bj * HALF + n * 16);
                        const f32x4 h = (x - mean) * rstd * g4[bj][n] + b4[bj][n];
                        *(f32x4*)(Cd + ro + bj * HALF + n * 16) = h * alpha + acc[ai][bj][m][n]; } }
    }
};
template <class Epi, class Sched, bool ALIGN_EPI = false, bool SP2 = false>
__device__ __forceinline__ void gemm_phase(PG8_LAS unsigned char* lds, const Gemm g, const Sched& S, const Epi& E) {
    const int tid = threadIdx.x, wid = __builtin_amdgcn_readfirstlane(tid >> 6), lane = tid & 63, wr = wid >> 2, wc = wid & 3, fr = lane & 15, fq = lane >> 4;
    const int K = g.K, nt = K / BK;
    unsigned voffA[2], voffB[2];
#pragma unroll
    for (int i = 0; i < 2; ++i) { int R, C; stage_rc(tid * 16 + i * 8192, R, C); const int Rb = Epi::PERM ? ((R & ~31) + perm32(R & 31)) : R;
        voffA[i] = (unsigned)(R * K + C) * 2u; voffB[i] = (unsigned)(Rb * K + C) * 2u; }
    const size_t kstep = (size_t)(BK * 2);
    const size_t hstep = (size_t)HALF * K * 2;
    const size_t tstep = 2 * hstep;
    const unsigned ldsw = (unsigned)wid * 1024u;
    const int aoff = lds_byte(wr * 64 + fr, fq * 8), boff = lds_byte(wc * 32 + fr, fq * 8);
#define PG8_SA(b, h) (((b) * 2 + (h)) * HTB)
#define PG8_SB(b, h) ((4 + (b) * 2 + (h)) * HTB)
#define PG8_STAGE(bufoff, gbase, voff) do { _Pragma("unroll") for (int _i = 0; _i < 2; ++_i) \
        __builtin_amdgcn_global_load_lds((const unsigned*)((const char*)(gbase) + (voff)[_i]), (PG8_LAS unsigned*)(lds + (bufoff) + ldsw + _i * 8192), 16, 0, 0); } while (0)
#define PG8_LDA(dst, b, h) do { _Pragma("unroll") for (int m = 0; m < 4; ++m) _Pragma("unroll") for (int k = 0; k < 2; ++k) dst[m][k] = *(const PG8_LAS bf16x8*)(lds + PG8_SA(b, h) + aoff + m * 2048 + k * 1024); } while (0)
#define PG8_LDB(dst, b, h) do { _Pragma("unroll") for (int n = 0; n < 2; ++n) _Pragma("unroll") for (int k = 0; k < 2; ++k) dst[n][k] = *(const PG8_LAS bf16x8*)(lds + PG8_SB(b, h) + boff + n * 2048 + k * 1024); } while (0)
#define PG8_MMA(ai, bj, At, Bt) do { __builtin_amdgcn_s_setprio(1); _Pragma("unroll") for (int m = 0; m < 4; ++m) _Pragma("unroll") for (int n = 0; n < 2; ++n) _Pragma("unroll") for (int k = 0; k < 2; ++k) \
        acc[ai][bj][m][n] = __builtin_amdgcn_mfma_f32_16x16x32_bf16(Bt[n][k], At[m][k], acc[ai][bj][m][n], 0, 0, 0); __builtin_amdgcn_s_setprio(0); } while (0)
#define PG8_WAIT_V(n) asm volatile("s_waitcnt vmcnt(" #n ")" ::: "memory")
#define PG8_WAIT_L(n) asm volatile("s_waitcnt lgkmcnt(" #n ")" ::: "memory")
#define PG8_BAR __builtin_amdgcn_s_barrier()
#define PG8_SCHED __builtin_amdgcn_sched_barrier(0)
    Unit cur, nxt; int ui = 0;
    if (!S.next(0, cur)) return;
    f32x4 acc[2][2][4][2];
#pragma unroll
    for (int a = 0; a < 2; ++a)
#pragma unroll
        for (int b = 0; b < 2; ++b)
#pragma unroll
            for (int m = 0; m < 4; ++m)
#pragma unroll
                for (int n = 0; n < 2; ++n) acc[a][b][m][n] = (f32x4){0.f, 0.f, 0.f, 0.f};
    bf16x8 At[4][2], B0[2][2], B1[2][2];
    const char* cA = (const char*)g.A + (size_t)cur.pm * tstep; const char* cB = (const char*)g.Bt + (size_t)cur.pn * tstep;
    S.a_ready(cur);
    if constexpr (SP2) {
        PG8_STAGE(PG8_SB(0, 0), cB, voffB); PG8_STAGE(PG8_SB(0, 1), cB + hstep, voffB); PG8_STAGE(PG8_SA(0, 0), cA, voffA); PG8_STAGE(PG8_SA(0, 1), cA + hstep, voffA);
        if (wr == 1) PG8_BAR;
        PG8_WAIT_V(2); PG8_BAR;
        PG8_STAGE(PG8_SB(1, 0), cB + kstep, voffB); PG8_STAGE(PG8_SA(1, 0), cA + kstep, voffA); PG8_STAGE(PG8_SB(1, 1), cB + hstep + kstep, voffB);
        PG8_WAIT_V(6); PG8_BAR;
    } else {
        PG8_STAGE(PG8_SB(0, 0), cB, voffB); PG8_STAGE(PG8_SA(0, 0), cA, voffA); PG8_STAGE(PG8_SB(0, 1), cB + hstep, voffB); PG8_STAGE(PG8_SA(0, 1), cA + hstep, voffA);
        if (wr == 1) PG8_BAR;
        PG8_WAIT_V(4); PG8_BAR;
        PG8_STAGE(PG8_SB(1, 0), cB + kstep, voffB); PG8_STAGE(PG8_SA(1, 0), cA + kstep, voffA); PG8_STAGE(PG8_SB(1, 1), cB + hstep + kstep, voffB);
        PG8_WAIT_V(6); PG8_BAR;
    }
    for (;;) {
        const bool has_next = S.next(ui + 1, nxt);
        const char* nA = has_next ? (const char*)g.A + (size_t)nxt.pm * tstep : cA; const char* nB = has_next ? (const char*)g.Bt + (size_t)nxt.pn * tstep : cB;
        for (int t = 0; t < nt; t += 2) {
            const bool last = (t == nt - 2);
            const char* a1 = cA + (size_t)(t + 1) * kstep;
            const char* a2 = last ? nA : cA + (size_t)(t + 2) * kstep; const char* b2 = last ? nB : cB + (size_t)(t + 2) * kstep;
            const char* a3 = a2 + kstep; const char* b3 = b2 + kstep;
            if (last && has_next) S.a_ready(nxt);
            if constexpr (SP2) {
            PG8_LDB(B0, 0, 0); PG8_LDB(B1, 0, 1); PG8_SCHED; PG8_LDA(At, 0, 0); PG8_STAGE(PG8_SA(1, 1), a1 + hstep, voffA);
            PG8_WAIT_V(8); PG8_WAIT_L(0); PG8_BAR; PG8_MMA(0, 0, At, B0); PG8_MMA(0, 1, At, B1); PG8_BAR; PG8_SCHED;
            PG8_LDA(At, 0, 1); PG8_STAGE(PG8_SB(0, 0), b2, voffB); PG8_STAGE(PG8_SB(0, 1), b2 + hstep, voffB); PG8_STAGE(PG8_SA(0, 0), a2, voffA);
            PG8_WAIT_V(8); PG8_WAIT_L(0); PG8_BAR; PG8_MMA(1, 0, At, B0); PG8_MMA(1, 1, At, B1); PG8_BAR; PG8_SCHED;
            PG8_LDB(B0, 1, 0); PG8_LDB(B1, 1, 1); PG8_SCHED; PG8_LDA(At, 1, 0); PG8_STAGE(PG8_SA(0, 1), a2 + hstep, voffA);
            PG8_WAIT_V(8); PG8_WAIT_L(0); PG8_BAR; PG8_MMA(0, 0, At, B0); PG8_MMA(0, 1, At, B1); PG8_BAR; PG8_SCHED;
            PG8_LDA(At, 1, 1); PG8_STAGE(PG8_SB(1, 0), b3, voffB); PG8_STAGE(PG8_SB(1, 1), b3 + hstep, voffB); PG8_STAGE(PG8_SA(1, 0), a3, voffA);
            PG8_WAIT_V(8); PG8_WAIT_L(0); PG8_BAR; PG8_MMA(1, 0, At, B0); PG8_MMA(1, 1, At, B1); PG8_BAR; PG8_SCHED;
            } else {
            PG8_LDB(B0, 0, 0); PG8_SCHED; PG8_LDA(At, 0, 0); PG8_STAGE(PG8_SA(1, 1), a1 + hstep, voffA);
            PG8_WAIT_L(8); PG8_BAR; PG8_WAIT_L(0); PG8_MMA(0, 0, At, B0); PG8_BAR; PG8_SCHED;
            PG8_LDB(B1, 0, 1); PG8_STAGE(PG8_SB(0, 0), b2, voffB);
            PG8_BAR; PG8_WAIT_L(0); PG8_MMA(0, 1, At, B1); PG8_BAR;
            PG8_LDA(At, 0, 1); PG8_STAGE(PG8_SA(0, 0), a2, voffA);
            PG8_BAR; PG8_WAIT_L(0); PG8_MMA(1, 0, At, B0); PG8_BAR; PG8_SCHED;
            PG8_STAGE(PG8_SB(0, 1), b2 + hstep, voffB);
            PG8_WAIT_V(6); PG8_BAR; PG8_MMA(1, 1, At, B1); PG8_BAR;
            PG8_LDB(B0, 1, 0); PG8_SCHED; PG8_LDA(At, 1, 0); PG8_STAGE(PG8_SA(0, 1), a2 + hstep, voffA);
            PG8_WAIT_L(8); PG8_BAR; PG8_WAIT_L(0); PG8_MMA(0, 0, At, B0); PG8_BAR; PG8_SCHED;
            PG8_LDB(B1, 1, 1); PG8_STAGE(PG8_SB(1, 0), b3, voffB);
            PG8_BAR; PG8_WAIT_L(0); PG8_MMA(0, 1, At, B1); PG8_BAR;
            PG8_LDA(At, 1, 1); PG8_STAGE(PG8_SA(1, 0), a3, voffA);
            PG8_BAR; PG8_WAIT_L(0); PG8_MMA(1, 0, At, B0); PG8_BAR; PG8_SCHED;
            PG8_STAGE(PG8_SB(1, 1), b3 + hstep, voffB);
            PG8_WAIT_V(6); PG8_BAR; PG8_MMA(1, 1, At, B1); PG8_BAR;
            }
        }
        if constexpr (ALIGN_EPI) { if (wr == 0) PG8_BAR; }
        if constexpr (!Epi::AFTER_DRAIN) { E(acc, cur, wr, wc, fr, fq); S.done(cur); }
        if (!has_next) break;
#pragma unroll
        for (int a = 0; a < 2; ++a)
#pragma unroll
            for (int b = 0; b < 2; ++b)
#pragma unroll
                for (int m = 0; m < 4; ++m)
#pragma unroll
                    for (int n = 0; n < 2; ++n) acc[a][b][m][n] = (f32x4){0.f, 0.f, 0.f, 0.f};
        cur = nxt; cA = nA; cB = nB; ++ui;
        if constexpr (ALIGN_EPI) { if (wr == 1) PG8_BAR; }
    }
    PG8_WAIT_V(0);
    if constexpr (!ALIGN_EPI) { if (wr == 0) PG8_BAR; }
    PG8_BAR;
    if constexpr (Epi::AFTER_DRAIN) { E.fused(acc, cur, wr, wc, fr, fq, lds, wid, lane); S.done(cur); }
#undef PG8_SA
#undef PG8_SB
#undef PG8_STAGE
#undef PG8_LDA
#undef PG8_LDB
#undef PG8_MMA
#undef PG8_WAIT_V
#undef PG8_WAIT_L
#undef PG8_BAR
#undef PG8_SCHED
}
}
constexpr int NB = 2, T = 8192, D = 4096, M = NB * T, DIN = 12452, LDZ = 12544, DFF = 16384, NLAYER = 2;
constexpr float LN_EPS = 1e-5f, NORM_EPS = 1e-6f;
constexpr float DN_ALPHA = 1.4142135623730951f;
constexpr int ZA_Q = 0, ZA_K = 1024, ZA_V = 1280, ZA_IQ = 1536, ZA_IK = 2048, ZB_Q = 2176, ZB_K = 2688, ZB_V = 3200, ZB_R = 4224,
              ZC_Q = 5248, ZC_K = 6272, ZC_V = 7296, ZC_G = 8320, ZD_Q = 9344, ZD_K = 10368, ZD_V = 11392,
              ZS_IW = 12416, ZS_GLR = 12420, ZS_CA = 12436, ZS_CB = 12444;
constexpr int MX_A = 0, MX_B = 1024, MX_C = 2048, MX_D = 3072;
constexpr size_t MiB = 1u << 20;
constexpr size_t WS_CTL = 0, CTL_ZERO_BYTES = 1 * MiB;
constexpr size_t WS_ROPE = 1 * MiB;
constexpr size_t WS_KMEAN = 5 * MiB;
constexpr size_t WS_IK = 9 * MiB;
constexpr size_t WS_GLA_DL = 6 * MiB;
constexpr size_t WS_GDN_DL = 7 * MiB;
constexpr size_t WS_STATS = 8 * MiB;
constexpr size_t WS_WIN = 16 * MiB, WIN_BYTES = (size_t)LDZ * D * 2;
constexpr size_t WS_WOUT = WS_WIN + 2 * WIN_BYTES, WOUT_BYTES = (size_t)D * D * 2;
constexpr size_t WS_WUP = WS_WOUT + 2 * WOUT_BYTES, WUP_BYTES = (size_t)DFF * D * 2;
constexpr size_t WS_WDN = WS_WUP + 2 * WUP_BYTES, WDN_BYTES = (size_t)D * DFF * 2;
constexpr size_t WS_HB = WS_WDN + 2 * WDN_BYTES;
constexpr size_t WS_Z = WS_HB + (size_t)M * D * 2;
constexpr size_t WS_MIX = WS_Z + (size_t)M * LDZ * 2;
constexpr size_t WS_FF = WS_Z;
constexpr size_t WS_SCR = WS_MIX + (size_t)M * D * 2;
static_assert(WS_FF + (size_t)M * DFF * 2 <= WS_SCR, "FF overlay");
constexpr size_t WS_GLA_HT = WS_SCR;
constexpr size_t WS_GLA_ST = WS_GLA_HT + (size_t)1024 * 256 * 128 * 4;
constexpr size_t WS_GDN_FR = WS_GLA_ST + (size_t)1024 * 256 * 128 * 2;
constexpr size_t WS_GDN_UT = WS_GDN_FR + (size_t)2048 * 57344;
constexpr size_t WS_GDN_O = WS_GDN_UT + (size_t)2048 * 128 * 64 * 4;
constexpr size_t WS_MASK = WS_GDN_O + (size_t)M * 1024 * 4;
constexpr size_t WS_VTA = WS_MASK + (size_t)M * 256 * 4;
constexpr size_t WS_VTD = WS_VTA + (size_t)2 * 2 * 128 * T * 2;
constexpr size_t WS_END = WS_VTD + (size_t)2 * 8 * 128 * T * 2;
static_assert(WS_END <= (size_t)2040 * MiB, "workspace budget");
constexpr int CW_BAR = 4096;
constexpr int CW_QUEUE = 8192;
constexpr int LDS_BYTES = 163840;
constexpr int MISC_OFF = LDS_BYTES - 256;
constexpr int NWAVES = 8, NTHREADS = 512;

#define GAS __attribute__((address_space(1)))
#define LAS __attribute__((address_space(3)))
typedef unsigned short bf16;
typedef unsigned v4u __attribute__((ext_vector_type(4)));
typedef unsigned v2u __attribute__((ext_vector_type(2)));
typedef float f32x4 __attribute__((ext_vector_type(4)));
typedef float f32x2 __attribute__((ext_vector_type(2)));
typedef float f32x16 __attribute__((ext_vector_type(16)));
typedef short bf16x8 __attribute__((ext_vector_type(8)));
typedef short bf16x4 __attribute__((ext_vector_type(4)));
typedef GAS unsigned gu32;
#define RLX_AGENT __ATOMIC_RELAXED, __HIP_MEMORY_SCOPE_AGENT
#define LDS_WAIT() asm volatile("s_waitcnt lgkmcnt(0)" ::: "memory")
#define VM_WAIT() asm volatile("s_waitcnt vmcnt(0)" ::: "memory")
__device__ __forceinline__ unsigned f2bf(float f) { unsigned u = __builtin_bit_cast(unsigned, f); return (u + 0x7fffu + ((u >> 16) & 1u)) >> 16; }
typedef __bf16 hbf16x2 __attribute__((ext_vector_type(2)));
__device__ __forceinline__ unsigned pk2(float lo, float hi) { const f32x2 v = {lo, hi}; return __builtin_bit_cast(unsigned, __builtin_convertvector(v, hbf16x2)); }
__device__ __forceinline__ float bf2f(unsigned h) { return __builtin_bit_cast(float, h << 16); }
__device__ __forceinline__ float bflo(unsigned w) { return __builtin_bit_cast(float, w << 16); }
__device__ __forceinline__ float bfhi(unsigned w) { return __builtin_bit_cast(float, w & 0xffff0000u); }
__device__ __forceinline__ float wave_sum(float v) {
#pragma unroll
    for (int o = 1; o < 64; o <<= 1) v += __shfl_xor(v, o);
    return v;
}
__device__ __forceinline__ float wave_max(float v) {
#pragma unroll
    for (int o = 1; o < 64; o <<= 1) v = fmaxf(v, __shfl_xor(v, o));
    return v;
}
__device__ __forceinline__ float wave_min(float v) {
#pragma unroll
    for (int o = 1; o < 64; o <<= 1) v = fminf(v, __shfl_xor(v, o));
    return v;
}
#define XB_TMO      128
#define XB_XCNT(j)  (256  + 64 * (j))
#define XB_XSUB(j)  (1280 + 64 * (j))
#define XB_XGEN(j)  (2304 + 64 * (j))
#define XB_TOP      3328
#define XB_TOPGEN   3392
#define XCD_BAR_WORDS 3456
#define XB_SPIN_CAP (1u << 18)

__device__ __forceinline__ unsigned xb_ld(unsigned* p)              { return __hip_atomic_load(p, __ATOMIC_RELAXED, __HIP_MEMORY_SCOPE_AGENT); }
__device__ __forceinline__ unsigned xb_add(unsigned* p, unsigned v) { return __hip_atomic_fetch_add(p, v, __ATOMIC_RELAXED, __HIP_MEMORY_SCOPE_AGENT); }
__device__ __forceinline__ unsigned xb_xcc_id() { return (unsigned)__builtin_amdgcn_s_getreg((3 << 11) | 20) & 0xFu; }
#define XB_SPIN(cond, bar) do { unsigned _sp = 0; while (cond) { __builtin_amdgcn_s_sleep(1); \
    if ((++_sp & 255u) == 0u) { if (xb_ld(&(bar)[XB_TMO])) break; if (_sp > XB_SPIN_CAP) { atomicAdd(&(bar)[XB_TMO], 1u); break; } } } } while (0)

struct XcdBarrier {
    unsigned* bar; unsigned x;
    volatile LAS unsigned* st;
};

__device__ __forceinline__ XcdBarrier xcd_barrier_post(unsigned* bar, volatile LAS unsigned* st) {
    XcdBarrier b; b.bar = bar; b.x = xb_xcc_id(); b.st = st;
    if (threadIdx.x == 0) (void)xb_add(&bar[XB_XCNT(b.x)], 1u);
    return b;
}
__device__ __forceinline__ void xcd_barrier_complete(unsigned* bar, unsigned x, unsigned& nloc, unsigned& nx) {
    const unsigned G = gridDim.x * gridDim.y * gridDim.z;
    unsigned sum, cnt, mine, sp = 0u;
    for (;;) {
        sum = 0u; cnt = 0u; mine = 0u;
#pragma unroll
        for (unsigned j = 0; j < 16; ++j) { const unsigned c = xb_ld(&bar[XB_XCNT(j)]); sum += c; cnt += (c > 0u) ? 1u : 0u; mine = (j == x) ? c : mine; }
        if (sum == G) break;
        __builtin_amdgcn_s_sleep(1);
        if ((++sp & 255u) == 0u) { if (xb_ld(&bar[XB_TMO])) break; if (sp > XB_SPIN_CAP) { atomicAdd(&bar[XB_TMO], 1u); break; } }
    }
    nloc = mine > 0u ? mine : 1u; nx = cnt > 0u ? cnt : 1u;
}

__device__ __forceinline__ void xcd_barrier(const XcdBarrier& b) {
    asm volatile("s_waitcnt vmcnt(0)" ::: "memory");
    __syncthreads();
    if (threadIdx.x == 0) {
        unsigned* bar = b.bar;
        __builtin_amdgcn_s_waitcnt(0);
        unsigned nloc = b.st[0], nx = b.st[1];
        if (nloc == 0u) { xcd_barrier_complete(bar, b.x, nloc, nx); b.st[0] = nloc; b.st[1] = nx; }
        const unsigned old = xb_add(&bar[XB_XSUB(b.x)], 1u);
        const unsigned gen = old / nloc;
        if (old + 1u == (gen + 1u) * nloc) {
            __builtin_amdgcn_fence(__ATOMIC_RELEASE, "agent");
            asm volatile("s_waitcnt vmcnt(0)" ::: "memory");
            const unsigned og = xb_add(&bar[XB_TOP], 1u);
            const unsigned tg = og / nx;
            if (og + 1u == (tg + 1u) * nx) xb_add(&bar[XB_TOPGEN], 1u);
            else XB_SPIN(xb_ld(&bar[XB_TOPGEN]) == tg, bar);
            __builtin_amdgcn_fence(__ATOMIC_ACQUIRE, "agent");
            xb_add(&bar[XB_XGEN(b.x)], 1u);
            asm volatile("s_waitcnt vmcnt(0)" ::: "memory");
        } else {
            XB_SPIN(xb_ld(&bar[XB_XGEN(b.x)]) == gen, bar);
            __builtin_amdgcn_fence(__ATOMIC_ACQUIRE, "agent");
            asm volatile("s_waitcnt vmcnt(0)" ::: "memory");
        }
    }
    __syncthreads();
}

struct Args { const float* in[18]; float* out; unsigned char* ws; int ph_lo, ph_hi, sub, qrep; };
struct Ctx {
    LAS unsigned char* lds; int tid, lane, wave, bid, G;
    unsigned char* ws; float* out;
};
__device__ __forceinline__ int q_next(const Ctx& C, gu32* head) {
    volatile LAS unsigned* slot = (volatile LAS unsigned*)(C.lds + MISC_OFF) + 2;
    __syncthreads();
    if (C.tid == 0) *slot = __hip_atomic_fetch_add(head, 1u, RLX_AGENT);
    __syncthreads();
    return (int)*slot;
}

__device__ __forceinline__ int win_src_col(int d) {
    if (d < 2176) return d;
    if (d < 4224) return d + 4;
    if (d < 8320) return d + 20;
    if (d < 12416) return d + 36;
    if (d < 12420) return 2176 + (d - 12416);
    if (d < 12436) return 4228 + (d - 12420);
    if (d < 12452) return 8340 + (d - 12436);
    return -1;
}
__device__ __forceinline__ void transpose_item(const float* W, int K, int N, bf16* WT, int ndest, bool mapped, LAS float* scr, int item, int lane) {
    const int nblk = ndest / 32, kb = item / nblk, nb = item % nblk, k0 = 64 * kb, n0 = 32 * nb;
    const int src = mapped ? win_src_col(n0 + (lane & 31)) : n0 + (lane & 31);
    float wv[32];
#pragma unroll
    for (int i = 0; i < 32; ++i) { const int kk = 2 * i + (lane >> 5); wv[i] = src >= 0 ? __builtin_nontemporal_load(W + (size_t)(k0 + kk) * N + src) : 0.f; }
#pragma unroll
    for (int i = 0; i < 32; ++i) { const int kk = 2 * i + (lane >> 5); scr[kk * 33 + (lane & 31)] = wv[i]; }
    LDS_WAIT(); asm volatile("" ::: "memory");
    const int c = lane & 7;
#pragma unroll
    for (int j = 0; j < 4; ++j) { const int n = (lane >> 3) + 8 * j; const LAS float* s = scr + (8 * c) * 33 + n;
        v4u o; o.x = pk2(s[0 * 33], s[1 * 33]); o.y = pk2(s[2 * 33], s[3 * 33]); o.z = pk2(s[4 * 33], s[5 * 33]); o.w = pk2(s[6 * 33], s[7 * 33]);
        *(GAS v4u*)(WT + (size_t)(n0 + n) * K + k0 + 8 * c) = o; }
    LDS_WAIT(); asm volatile("" ::: "memory");
}
__device__ __forceinline__ void sincos_own(double a, float& co, float& si) {
    const double k = __builtin_rint(a * 0.6366197723675814);
    const double r = __builtin_fma(-k, 1.5707963267948966, a) - k * 6.123233995736766e-17;
    const int q = ((int)k) & 3;
    const double r2 = r * r;
    double sp = 1.6059043836821613e-10; sp = sp * r2 - 2.505210838544172e-08; sp = sp * r2 + 2.7557319223985893e-06; sp = sp * r2 - 0.0001984126984126984; sp = sp * r2 + 0.008333333333333333; sp = sp * r2 - 0.16666666666666666; sp = sp * r2 * r + r;
    double cp = -1.1470745597729725e-11; cp = cp * r2 + 2.08767569878681e-09; cp = cp * r2 - 2.755731922398589e-07; cp = cp * r2 + 2.48015873015873e-05; cp = cp * r2 - 0.001388888888888889; cp = cp * r2 + 0.041666666666666664; cp = cp * r2 - 0.5; cp = cp * r2 + 1.0;
    const double cc = (q == 0) ? cp : (q == 1) ? -sp : (q == 2) ? -cp : sp;
    const double ss = (q == 0) ? sp : (q == 1) ? cp : (q == 2) ? -sp : -cp;
    co = (float)cc; si = (float)ss;
}
__device__ __forceinline__ void ln_row(const float* xrow, float* orow, bf16* obrow, float* st, const float* g, const float* b, int lane) {
    const GAS f32x4* xr = (const GAS f32x4*)xrow + lane;
    f32x4 v[16]; float s = 0.f;
#pragma unroll
    for (int j = 0; j < 16; ++j) { v[j] = xr[64 * j]; s += (v[j].x + v[j].y) + (v[j].z + v[j].w); }
    const float mean = wave_sum(s) * (1.f / D); float s2 = 0.f;
#pragma unroll
    for (int j = 0; j < 16; ++j) { v[j] = v[j] - mean; s2 += (v[j].x * v[j].x + v[j].y * v[j].y) + (v[j].z * v[j].z + v[j].w * v[j].w); }
    const float rstd = 1.f / sqrtf(wave_sum(s2) * (1.f / D) + LN_EPS);
    if (st && lane == 0) *(GAS f32x2*)st = (f32x2){mean, rstd};
    GAS f32x4* o4 = (GAS f32x4*)orow + lane; GAS v2u* o8 = (GAS v2u*)obrow + lane;
    const GAS f32x4* g4 = (const GAS f32x4*)g + lane; const GAS f32x4* b4 = (const GAS f32x4*)b + lane;
#pragma unroll
    for (int j = 0; j < 16; ++j) { const f32x4 o = v[j] * rstd * g4[64 * j] + b4[64 * j]; if (orow) o4[64 * j] = o; if (obrow) { v2u w; w.x = pk2(o.x, o.y); w.y = pk2(o.z, o.w); o8[64 * j] = w; } }
}
__device__ __forceinline__ void ln_phase(const Ctx& C, const float* src, float* dst, bf16* dstb, float* st, const float* g, const float* b) {
    const int gw = C.bid * NWAVES + C.wave, NGW = C.G * NWAVES;
    for (int m = gw; m < M; m += NGW) ln_row(src + (size_t)m * D, dst ? dst + (size_t)m * D : nullptr, dstb ? dstb + (size_t)m * D : nullptr, st ? st + 2 * m : nullptr, g, b, C.lane);
}
__device__ __forceinline__ void init_phase(const Ctx& C, const Args& A) {
    LAS float* scr = (LAS float*)(C.lds + C.wave * 16384);
    const int gw = C.bid * NWAVES + C.wave, NGW = C.G * NWAVES;
    constexpr int I_IN = (D / 64) * (LDZ / 32), I_OUT = (D / 64) * (D / 32), I_UP = (D / 64) * (DFF / 32), I_DN = (DFF / 64) * (D / 32);
    constexpr int I_LAYER = I_IN + I_OUT + I_UP + I_DN;
    for (int it = gw; it < NLAYER * I_LAYER; it += NGW) {
        const int l = it / I_LAYER; int r = it % I_LAYER;
        if (r < I_IN) { transpose_item(A.in[3] + (size_t)l * D * DIN, D, DIN, (bf16*)(C.ws + WS_WIN + l * WIN_BYTES), LDZ, true, scr, r, C.lane); continue; } r -= I_IN;
        if (r < I_OUT) { transpose_item(A.in[4] + (size_t)l * D * D, D, D, (bf16*)(C.ws + WS_WOUT + l * WOUT_BYTES), D, false, scr, r, C.lane); continue; } r -= I_OUT;
        if (r < I_UP) { transpose_item(A.in[14] + (size_t)l * D * DFF, D, DFF, (bf16*)(C.ws + WS_WUP + l * WUP_BYTES), DFF, false, scr, r, C.lane); continue; } r -= I_UP;
        transpose_item(A.in[15] + (size_t)l * DFF * D, DFF, D, (bf16*)(C.ws + WS_WDN + l * WDN_BYTES), D, false, scr, r, C.lane);
    }
    { f32x2* rope = (f32x2*)(C.ws + WS_ROPE);
      for (int idx = C.bid * NTHREADS + C.tid; idx < T * 64; idx += C.G * NTHREADS) {
          const int t = idx >> 6, i = idx & 63; double p = 1.0; for (int k = 0; k < i; ++k) p *= 0.8659643233600653;
          const float inv = (float)p; const float ang = (float)t * inv; float co, si; sincos_own((double)ang, co, si);
          rope[idx] = (f32x2){co, si}; } }
    ln_phase(C, A.in[0], nullptr, (bf16*)(C.ws + WS_HB), (float*)(C.ws + WS_STATS), A.in[1], A.in[2]);
}
#define MFMA16(a, b, c) __builtin_amdgcn_mfma_f32_16x16x32_bf16(a, b, c, 0, 0, 0)
#define MFMA32(a, b, c) __builtin_amdgcn_mfma_f32_32x32x16_bf16(a, b, c, 0, 0, 0)
__device__ __forceinline__ float log_sigmoidf(float x) { return fminf(x, 0.f) - log1pf(__expf(-fabsf(x))); }
__device__ __forceinline__ float siluf(float x) { return x / (1.f + __expf(-x)); }
constexpr int GL_GLR = 0, GL_W2H = 4096, GL_BIAS = 12288, GL_BCUM = 12800, GL_GT = 45568;
constexpr int G1_K2T = 47616, G1_VT = 66048;
constexpr int G3_QT = 47616, G3_KT = 65024, G3_VT = 82432, G3_ATT = 119296, G3_SS = 128512;
__device__ __forceinline__ void gla_bcum(const Ctx& C, const bf16* Z, const float* w2, const float* gb, int b, int h, int c) {
    LAS float* GLR = (LAS float*)(C.lds + GL_GLR); LAS float* W2H = (LAS float*)(C.lds + GL_W2H); LAS float* BIAS = (LAS float*)(C.lds + GL_BIAS);
    LAS float* BCUM = (LAS float*)(C.lds + GL_BCUM); LAS float* GT = (LAS float*)(C.lds + GL_GT);
    const size_t m0 = (size_t)b * T + (size_t)c * 64;
    {
        bf16 g0[2]; float w0[4]; float bi0 = 0.f;
#pragma unroll
        for (int k = 0; k < 2; ++k) { const int e = C.tid + k * NTHREADS; g0[k] = Z[(m0 + (e >> 4)) * LDZ + ZS_GLR + (e & 15)]; }
#pragma unroll
        for (int k = 0; k < 4; ++k) { const int e = C.tid + k * NTHREADS; w0[k] = w2[(e >> 7) * 512 + h * 128 + (e & 127)]; }
        if (C.tid < 128) bi0 = gb[h * 128 + C.tid];
#pragma unroll
        for (int k = 0; k < 2; ++k) GLR[C.tid + k * NTHREADS] = bf2f(g0[k]);
#pragma unroll
        for (int k = 0; k < 4; ++k) W2H[C.tid + k * NTHREADS] = w0[k];
        if (C.tid < 128) BIAS[C.tid] = bi0;
    }
    __syncthreads();
    const int d = C.tid & 127, grp = C.tid >> 7;
    float wcol[16];
#pragma unroll
    for (int r = 0; r < 16; ++r) wcol[r] = W2H[r * 128 + d];
    const float bi = BIAS[d];
    float cum[16]; float run = 0.f;
#pragma unroll
    for (int jj = 0; jj < 16; ++jj) { const int j = grp * 16 + jj; float x = bi;
#pragma unroll
        for (int r = 0; r < 16; ++r) x += GLR[j * 16 + r] * wcol[r];
        run += log_sigmoidf(x) * (1.f / 16.f); cum[jj] = run; }
    GT[grp * 128 + d] = run;
    __syncthreads();
    float off = 0.f;
#pragma unroll
    for (int g = 0; g < 3; ++g) if (g < grp) off += GT[g * 128 + d];
#pragma unroll
    for (int jj = 0; jj < 16; ++jj) BCUM[(grp * 16 + jj) * 128 + d] = cum[jj] + off;
    __syncthreads();
}
__device__ __forceinline__ void gla_b1_unit(const Ctx& C, const bf16* Z, const float* w2, const float* gb, int unit) {
    const int c = unit & 127, h = (unit >> 7) & 3, b = unit >> 9;
    gla_bcum(C, Z, w2, gb, b, h, c);
    LAS float* BCUM = (LAS float*)(C.lds + GL_BCUM); LAS bf16* K2T = (LAS bf16*)(C.lds + G1_K2T); LAS bf16* VT = (LAS bf16*)(C.lds + G1_VT);
    const size_t m0 = (size_t)b * T + (size_t)c * 64;
    for (int e = C.tid; e < 64 * 16; e += NTHREADS) { const int j = e >> 4, dg = e & 15;
        const v4u kv = *(const GAS v4u*)(Z + (m0 + j) * LDZ + ZB_K + h * 128 + dg * 8); const unsigned kw[4] = {kv.x, kv.y, kv.z, kv.w};
#pragma unroll
        for (int q = 0; q < 4; ++q) { const int d = dg * 8 + 2 * q;
            const float e0 = __expf(BCUM[63 * 128 + d] - BCUM[j * 128 + d]), e1 = __expf(BCUM[63 * 128 + d + 1] - BCUM[j * 128 + d + 1]);
            K2T[d * 72 + j] = (bf16)f2bf(bflo(kw[q]) * e0); K2T[(d + 1) * 72 + j] = (bf16)f2bf(bfhi(kw[q]) * e1); } }
    for (int e = C.tid; e < 64 * 32; e += NTHREADS) { const int j = e >> 5, vg = e & 31;
        const v4u vv = *(const GAS v4u*)(Z + (m0 + j) * LDZ + ZB_V + h * 256 + vg * 8); const unsigned vw[4] = {vv.x, vv.y, vv.z, vv.w};
#pragma unroll
        for (int q = 0; q < 4; ++q) { const int dv = vg * 8 + 2 * q; VT[dv * 72 + j] = (bf16)(vw[q] & 0xffffu); VT[(dv + 1) * 72 + j] = (bf16)(vw[q] >> 16); } }
    if (C.tid < 128) ((float*)(C.ws + WS_GLA_DL))[(size_t)unit * 128 + C.tid] = __expf(BCUM[63 * 128 + C.tid]);
    __syncthreads();
    const int row = C.lane & 15, kg = C.lane >> 4;
    f32x4 acc[2][8];
#pragma unroll
    for (int mt = 0; mt < 2; ++mt)
#pragma unroll
        for (int nt = 0; nt < 8; ++nt) acc[mt][nt] = (f32x4){0.f, 0.f, 0.f, 0.f};
#pragma unroll
    for (int ks = 0; ks < 2; ++ks) {
        bf16x8 af[2];
#pragma unroll
        for (int mt = 0; mt < 2; ++mt) af[mt] = *(const LAS bf16x8*)(VT + (C.wave * 32 + mt * 16 + row) * 72 + ks * 32 + kg * 8);
#pragma unroll
        for (int nt = 0; nt < 8; ++nt) { const bf16x8 bfr = *(const LAS bf16x8*)(K2T + (nt * 16 + row) * 72 + ks * 32 + kg * 8);
#pragma unroll
            for (int mt = 0; mt < 2; ++mt) acc[mt][nt] = MFMA16(af[mt], bfr, acc[mt][nt]); }
    }
    float* HT = (float*)(C.ws + WS_GLA_HT) + (size_t)unit * 256 * 128;
#pragma unroll
    for (int mt = 0; mt < 2; ++mt)
#pragma unroll
        for (int nt = 0; nt < 8; ++nt)
#pragma unroll
            for (int r = 0; r < 4; ++r) HT[(size_t)(C.wave * 32 + mt * 16 + kg * 4 + r) * 128 + nt * 16 + row] = acc[mt][nt][r];
    __syncthreads();
}
__device__ __forceinline__ void gla_b2_unit(const Ctx& C, int unit) {
    const int idx = unit * NTHREADS + C.tid; const int d4 = idx & 31, dv = (idx >> 5) & 255, bh = idx >> 13;
    const float* HT = (const float*)(C.ws + WS_GLA_HT) + ((size_t)bh * 128 * 256 + dv) * 128 + d4 * 4;
    const float* DL = (const float*)(C.ws + WS_GLA_DL) + (size_t)bh * 128 * 128 + d4 * 4;
    bf16* ST = (bf16*)(C.ws + WS_GLA_ST) + ((size_t)bh * 128 * 256 + dv) * 128 + d4 * 4;
    f32x4 S = (f32x4){0.f, 0.f, 0.f, 0.f};
#pragma unroll 4
    for (int c = 0; c < 128; ++c) {
        const f32x4 hv = *(const GAS f32x4*)(HT + (size_t)c * 256 * 128); const f32x4 dl = *(const GAS f32x4*)(DL + (size_t)c * 128);
        v2u w; w.x = pk2(S.x, S.y); w.y = pk2(S.z, S.w); *(GAS v2u*)(ST + (size_t)c * 256 * 128) = w;
        S = dl * S + hv;
    }
}
__device__ __forceinline__ void gla_b3_unit(const Ctx& C, const bf16* Z, bf16* MIX, const float* w2, const float* gb, const float* ng, int unit) {
    const int c = unit & 127, h = (unit >> 7) & 3, b = unit >> 9;
    gla_bcum(C, Z, w2, gb, b, h, c);
    LAS float* BCUM = (LAS float*)(C.lds + GL_BCUM); LAS bf16* QT = (LAS bf16*)(C.lds + G3_QT); LAS bf16* KT = (LAS bf16*)(C.lds + G3_KT);
    LAS bf16* VT = (LAS bf16*)(C.lds + G3_VT); LAS bf16* ATT = (LAS bf16*)(C.lds + G3_ATT); LAS float* SS = (LAS float*)(C.lds + G3_SS);
    const size_t m0 = (size_t)b * T + (size_t)c * 64;
    for (int e = C.tid; e < 64 * 16; e += NTHREADS) { const int j = e >> 4, dg = e & 15;
        const v4u qv = *(const GAS v4u*)(Z + (m0 + j) * LDZ + ZB_Q + h * 128 + dg * 8); const v4u kv = *(const GAS v4u*)(Z + (m0 + j) * LDZ + ZB_K + h * 128 + dg * 8);
        const unsigned qw[4] = {qv.x, qv.y, qv.z, qv.w}, kw[4] = {kv.x, kv.y, kv.z, kv.w}; unsigned qo[4], ko[4];
#pragma unroll
        for (int q = 0; q < 4; ++q) { const int d = dg * 8 + 2 * q; const float b0 = BCUM[j * 128 + d], b1 = BCUM[j * 128 + d + 1];
            qo[q] = pk2(bflo(qw[q]) * 0.08838834764831845f * __expf(b0), bfhi(qw[q]) * 0.08838834764831845f * __expf(b1));
            ko[q] = pk2(bflo(kw[q]) * __expf(-b0), bfhi(kw[q]) * __expf(-b1)); }
        *(LAS v4u*)(QT + j * 136 + dg * 8) = (v4u){qo[0], qo[1], qo[2], qo[3]}; *(LAS v4u*)(KT + j * 136 + dg * 8) = (v4u){ko[0], ko[1], ko[2], ko[3]}; }
    for (int e = C.tid; e < 64 * 32; e += NTHREADS) { const int j = e >> 5, vg = e & 31;
        const v4u vv = *(const GAS v4u*)(Z + (m0 + j) * LDZ + ZB_V + h * 256 + vg * 8); const unsigned vw[4] = {vv.x, vv.y, vv.z, vv.w};
#pragma unroll
        for (int q = 0; q < 4; ++q) { const int dv = vg * 8 + 2 * q; VT[dv * 72 + j] = (bf16)(vw[q] & 0xffffu); VT[(dv + 1) * 72 + j] = (bf16)(vw[q] >> 16); } }
    __syncthreads();
    const int row = C.lane & 15, kg = C.lane >> 4;
    {
        const int mt = C.wave >> 1; f32x4 a2[2] = {(f32x4){0.f, 0.f, 0.f, 0.f}, (f32x4){0.f, 0.f, 0.f, 0.f}};
#pragma unroll
        for (int ks = 0; ks < 4; ++ks) { const bf16x8 af = *(const LAS bf16x8*)(QT + (mt * 16 + row) * 136 + ks * 32 + kg * 8);
#pragma unroll
            for (int n2 = 0; n2 < 2; ++n2) { const int nt = (C.wave & 1) * 2 + n2; const bf16x8 bfr = *(const LAS bf16x8*)(KT + (nt * 16 + row) * 136 + ks * 32 + kg * 8); a2[n2] = MFMA16(af, bfr, a2[n2]); } }
#pragma unroll
        for (int n2 = 0; n2 < 2; ++n2) { const int j = ((C.wave & 1) * 2 + n2) * 16 + row;
#pragma unroll
            for (int r = 0; r < 4; ++r) { const int i = mt * 16 + kg * 4 + r; ATT[i * 72 + j] = (bf16)f2bf(j <= i ? a2[n2][r] : 0.f); } }
    }
    __syncthreads();
    const int wr = C.wave >> 2, wc = C.wave & 3;
    f32x4 acc[2][4];
#pragma unroll
    for (int mt = 0; mt < 2; ++mt)
#pragma unroll
        for (int nt = 0; nt < 4; ++nt) acc[mt][nt] = (f32x4){0.f, 0.f, 0.f, 0.f};
#pragma unroll
    for (int ks = 0; ks < 2; ++ks) { bf16x8 af[2];
#pragma unroll
        for (int mt = 0; mt < 2; ++mt) af[mt] = *(const LAS bf16x8*)(ATT + (wr * 32 + mt * 16 + row) * 72 + ks * 32 + kg * 8);
#pragma unroll
        for (int nt = 0; nt < 4; ++nt) { const bf16x8 bfr = *(const LAS bf16x8*)(VT + (wc * 64 + nt * 16 + row) * 72 + ks * 32 + kg * 8);
#pragma unroll
            for (int mt = 0; mt < 2; ++mt) acc[mt][nt] = MFMA16(af[mt], bfr, acc[mt][nt]); } }
    const bf16* ST = (const bf16*)(C.ws + WS_GLA_ST) + (size_t)unit * 256 * 128;
#pragma unroll
    for (int ks = 0; ks < 4; ++ks) { bf16x8 af[2];
#pragma unroll
        for (int mt = 0; mt < 2; ++mt) af[mt] = *(const LAS bf16x8*)(QT + (wr * 32 + mt * 16 + row) * 136 + ks * 32 + kg * 8);
#pragma unroll
        for (int nt = 0; nt < 4; ++nt) { const bf16x8 bfr = *(const GAS bf16x8*)(ST + (size_t)(wc * 64 + nt * 16 + row) * 128 + ks * 32 + kg * 8);
#pragma unroll
            for (int mt = 0; mt < 2; ++mt) acc[mt][nt] = MFMA16(af[mt], bfr, acc[mt][nt]); } }
#pragma unroll
    for (int mt = 0; mt < 2; ++mt)
#pragma unroll
        for (int r = 0; r < 4; ++r) { float s = 0.f;
#pragma unroll
            for (int nt = 0; nt < 4; ++nt) s += acc[mt][nt][r] * acc[mt][nt][r];
            s += __shfl_xor(s, 1); s += __shfl_xor(s, 2); s += __shfl_xor(s, 4); s += __shfl_xor(s, 8);
            if (row == 0) SS[(wr * 32 + mt * 16 + kg * 4 + r) * 4 + wc] = s; }
    __syncthreads();
#pragma unroll
    for (int mt = 0; mt < 2; ++mt)
#pragma unroll
        for (int r = 0; r < 4; ++r) { const int i = wr * 32 + mt * 16 + kg * 4 + r; const f32x4 s4 = *(const LAS f32x4*)(SS + i * 4);
            const float rstd = 1.f / sqrtf(((s4.x + s4.y) + (s4.z + s4.w)) * (1.f / 256.f) + NORM_EPS);
#pragma unroll
            for (int nt = 0; nt < 4; ++nt) { const int dv = wc * 64 + nt * 16 + row;
                const float gate = siluf(bf2f(Z[(m0 + i) * LDZ + ZB_R + h * 256 + dv]));
                MIX[(m0 + i) * D + MX_B + h * 256 + dv] = (bf16)f2bf(acc[mt][nt][r] * rstd * ng[dv] * gate); } }
    __syncthreads();
}
constexpr int C1_GAM = 0, C1_BETA = 256, C1_AM = 1024, C1_KF = 17408, C1_VF = 50176, C1_QB = 82944, C1_KB = 100352, C1_AQK = 117760;
constexpr int C1_WB = 17408, C1_QH = 34816, C1_KHT = 52224;
__device__ __forceinline__ float softplusf(float x) { return fmaxf(x, 0.f) + log1pf(__expf(-fabsf(x))); }
__device__ __forceinline__ void gdn_c1_unit(const Ctx& C, const bf16* Z, const float* convw, const float* alog, const float* dtb, int unit) {
    const int c = unit & 127, h = (unit >> 7) & 7, b = unit >> 10;
    LAS float* GAM = (LAS float*)(C.lds + C1_GAM); LAS float* BETA = (LAS float*)(C.lds + C1_BETA);
    LAS float* KF = (LAS float*)(C.lds + C1_KF); LAS float* VF = (LAS float*)(C.lds + C1_VF);
    LAS bf16* QB = (LAS bf16*)(C.lds + C1_QB); LAS bf16* KB = (LAS bf16*)(C.lds + C1_KB);
    LAS float* AM = (LAS float*)(C.lds + C1_AM); LAS bf16* AQK = (LAS bf16*)(C.lds + C1_AQK);
    const size_t m0 = (size_t)b * T + (size_t)c * 64;
    {   const int dg = C.tid & 15, tA = C.tid >> 4;
        float val[2][3][8];
#pragma unroll
        for (int p = 0; p < 3; ++p) { const int zc = (p == 0 ? ZC_Q : p == 1 ? ZC_K : ZC_V) + h * 128 + dg * 8; const int ch = p * 1024 + h * 128 + dg * 8;
            f32x4 w0[4], w1[4]; v4u xv[2][4];
#pragma unroll
            for (int i = 0; i < 4; ++i) { w0[i] = *(const GAS f32x4*)(convw + i * 3072 + ch); w1[i] = *(const GAS f32x4*)(convw + i * 3072 + ch + 4); }
#pragma unroll
            for (int it = 0; it < 2; ++it)
#pragma unroll
                for (int i = 0; i < 4; ++i) { const int tt = c * 64 + tA + 32 * it - 3 + i; const v4u x = *(const GAS v4u*)(Z + ((size_t)b * T + (tt < 0 ? 0 : tt)) * LDZ + zc);
                    xv[it][i] = tt < 0 ? (v4u){0u, 0u, 0u, 0u} : x; }
#pragma unroll
            for (int it = 0; it < 2; ++it) {
#pragma unroll
                for (int q = 0; q < 8; ++q) val[it][p][q] = 0.f;
#pragma unroll
                for (int i = 0; i < 4; ++i) { const unsigned xw[4] = {xv[it][i].x, xv[it][i].y, xv[it][i].z, xv[it][i].w};
                    val[it][p][0] += bflo(xw[0]) * w0[i].x; val[it][p][1] += bfhi(xw[0]) * w0[i].y; val[it][p][2] += bflo(xw[1]) * w0[i].z; val[it][p][3] += bfhi(xw[1]) * w0[i].w;
                    val[it][p][4] += bflo(xw[2]) * w1[i].x; val[it][p][5] += bfhi(xw[2]) * w1[i].y; val[it][p][6] += bflo(xw[3]) * w1[i].z; val[it][p][7] += bfhi(xw[3]) * w1[i].w; }
#pragma unroll
                for (int q = 0; q < 8; ++q) val[it][p][q] = siluf(val[it][p][q]); } }
#pragma unroll
        for (int it = 0; it < 2; ++it) { const int t = tA + 32 * it;
            float sq = 0.f, sk = 0.f;
#pragma unroll
            for (int q = 0; q < 8; ++q) { sq += val[it][0][q] * val[it][0][q]; sk += val[it][1][q] * val[it][1][q]; }
            sq += __shfl_xor(sq, 1); sq += __shfl_xor(sq, 2); sq += __shfl_xor(sq, 4); sq += __shfl_xor(sq, 8);
            sk += __shfl_xor(sk, 1); sk += __shfl_xor(sk, 2); sk += __shfl_xor(sk, 4); sk += __shfl_xor(sk, 8);
            const float rq = 0.08838834764831845f / sqrtf(sq + NORM_EPS), rk = 1.f / sqrtf(sk + NORM_EPS);
#pragma unroll
            for (int q = 0; q < 8; ++q) { val[it][0][q] *= rq; val[it][1][q] *= rk; }
            *(LAS f32x4*)(KF + t * 128 + dg * 8) = (f32x4){val[it][1][0], val[it][1][1], val[it][1][2], val[it][1][3]}; *(LAS f32x4*)(KF + t * 128 + dg * 8 + 4) = (f32x4){val[it][1][4], val[it][1][5], val[it][1][6], val[it][1][7]};
            *(LAS f32x4*)(VF + t * 128 + dg * 8) = (f32x4){val[it][2][0], val[it][2][1], val[it][2][2], val[it][2][3]}; *(LAS f32x4*)(VF + t * 128 + dg * 8 + 4) = (f32x4){val[it][2][4], val[it][2][5], val[it][2][6], val[it][2][7]};
            *(LAS v4u*)(QB + t * 136 + dg * 8) = (v4u){pk2(val[it][0][0], val[it][0][1]), pk2(val[it][0][2], val[it][0][3]), pk2(val[it][0][4], val[it][0][5]), pk2(val[it][0][6], val[it][0][7])};
            *(LAS v4u*)(KB + t * 136 + dg * 8) = (v4u){pk2(val[it][1][0], val[it][1][1]), pk2(val[it][1][2], val[it][1][3]), pk2(val[it][1][4], val[it][1][5]), pk2(val[it][1][6], val[it][1][7])}; }
    }
    if (C.wave == 0) { const int t = C.lane;
        const float cb = bf2f(Z[(m0 + t) * LDZ + ZS_CB + h]), ca = bf2f(Z[(m0 + t) * LDZ + ZS_CA + h]);
        const float beta = 1.f / (1.f + __expf(-cb)); float g = -__expf(alog[h]) * softplusf(ca + dtb[h]);
#pragma unroll
        for (int o = 1; o < 64; o <<= 1) { const float n = __shfl_up(g, o); if (C.lane >= o) g += n; }
        GAM[t] = g; BETA[t] = beta; }
    __syncthreads();
    const int row = C.lane & 15, kg = C.lane >> 4;
    {
        const int mt = C.wave >> 1; f32x4 akk[2], aqk[2];
#pragma unroll
        for (int n2 = 0; n2 < 2; ++n2) { akk[n2] = (f32x4){0.f, 0.f, 0.f, 0.f}; aqk[n2] = (f32x4){0.f, 0.f, 0.f, 0.f}; }
#pragma unroll
        for (int ks = 0; ks < 4; ++ks) { const bf16x8 ak = *(const LAS bf16x8*)(KB + (mt * 16 + row) * 136 + ks * 32 + kg * 8), aq = *(const LAS bf16x8*)(QB + (mt * 16 + row) * 136 + ks * 32 + kg * 8);
#pragma unroll
            for (int n2 = 0; n2 < 2; ++n2) { const int nt = (C.wave & 1) * 2 + n2; const bf16x8 bfr = *(const LAS bf16x8*)(KB + (nt * 16 + row) * 136 + ks * 32 + kg * 8);
                akk[n2] = MFMA16(ak, bfr, akk[n2]); aqk[n2] = MFMA16(aq, bfr, aqk[n2]); } }
#pragma unroll
        for (int n2 = 0; n2 < 2; ++n2) { const int j = ((C.wave & 1) * 2 + n2) * 16 + row; const float gj = GAM[j];
#pragma unroll
            for (int r = 0; r < 4; ++r) { const int i = mt * 16 + kg * 4 + r; const float dec = (j <= i) ? __expf(GAM[i] - gj) : 0.f;
                AM[i * 64 + j] = (j < i) ? BETA[i] * dec * akk[n2][r] : 0.f; AQK[i * 72 + j] = (bf16)f2bf(aqk[n2][r] * dec); } }
    }
    __syncthreads();
    float x[64];
    if (C.tid < 256) { const int cc = C.tid & 127; const bool isw = C.tid >= 128;
#pragma unroll
        for (int i = 0; i < 64; ++i) x[i] = isw ? BETA[i] * __expf(GAM[i]) * KF[i * 128 + cc] : BETA[i] * VF[i * 128 + cc]; }
    __syncthreads();
    if (C.tid < 256) {
#pragma unroll
        for (int i = 1; i < 64; ++i) { float s0 = 0.f, s1 = 0.f;
#pragma unroll
            for (int j4 = 0; j4 < (i + 3) / 4; ++j4) { const f32x4 a = *(const LAS f32x4*)(AM + i * 64 + j4 * 4);
                s0 += a.x * x[j4 * 4]; s1 += a.y * x[j4 * 4 + 1]; s0 += a.z * x[j4 * 4 + 2]; s1 += a.w * x[j4 * 4 + 3]; }
            x[i] -= (s0 + s1); asm volatile("" ::: "memory"); }
        const int cc = C.tid & 127;
        if (C.tid < 128) { float* UT = (float*)(C.ws + WS_GDN_UT) + ((size_t)unit * 128 + cc) * 64;
#pragma unroll
            for (int i4 = 0; i4 < 16; ++i4) *(GAS f32x4*)(UT + i4 * 4) = (f32x4){x[i4 * 4], x[i4 * 4 + 1], x[i4 * 4 + 2], x[i4 * 4 + 3]}; }
        else { LAS bf16* WB = (LAS bf16*)(C.lds + C1_WB);
#pragma unroll
            for (int i = 0; i < 64; ++i) WB[i * 136 + cc] = (bf16)f2bf(x[i]); }
    } else {
        LAS bf16* QH = (LAS bf16*)(C.lds + C1_QH); LAS bf16* KHT = (LAS bf16*)(C.lds + C1_KHT); const float gl = GAM[63];
        for (int e = C.tid - 256; e < 64 * 16; e += 256) { const int i = e >> 4, dg = e & 15; const float eq = __expf(GAM[i]), ek = __expf(gl - GAM[i]);
            const v4u qv = *(const LAS v4u*)(QB + i * 136 + dg * 8), kv = *(const LAS v4u*)(KB + i * 136 + dg * 8); const unsigned qw[4] = {qv.x, qv.y, qv.z, qv.w}, kw[4] = {kv.x, kv.y, kv.z, kv.w};
            *(LAS v4u*)(QH + i * 136 + dg * 8) = (v4u){pk2(bflo(qw[0]) * eq, bfhi(qw[0]) * eq), pk2(bflo(qw[1]) * eq, bfhi(qw[1]) * eq), pk2(bflo(qw[2]) * eq, bfhi(qw[2]) * eq), pk2(bflo(qw[3]) * eq, bfhi(qw[3]) * eq)};
#pragma unroll
            for (int q = 0; q < 4; ++q) { KHT[(dg * 8 + 2 * q) * 72 + i] = (bf16)f2bf(bflo(kw[q]) * ek); KHT[(dg * 8 + 2 * q + 1) * 72 + i] = (bf16)f2bf(bfhi(kw[q]) * ek); } }
        if (C.tid == 256) ((float*)(C.ws + WS_GDN_DL))[unit] = __expf(gl);
    }
    __syncthreads();
    {   LAS bf16* WB = (LAS bf16*)(C.lds + C1_WB); LAS bf16* QH = (LAS bf16*)(C.lds + C1_QH); LAS bf16* KHT = (LAS bf16*)(C.lds + C1_KHT);
        bf16* FR = (bf16*)(C.ws + WS_GDN_FR) + (size_t)unit * 28672;
        const int r = C.lane & 31, hh = C.lane >> 5;
        for (int i = C.wave; i < 54; i += NWAVES) { const LAS bf16* src; const int f = i < 24 ? i : i < 26 ? 24 + i : i < 34 ? i - 2 : i < 38 ? 18 + i : i - 6;
            if (f < 32) { const int g = f & 15, mt = g >> 3, t = (g >> 1) & 3, s = g & 1; src = (f < 16 ? WB : QH) + (32 * mt + r) * 136 + 32 * t + 16 * s + 4 * hh; }
            else if (f < 48) { const int g = f - 32, t = g >> 2, mt = (g >> 1) & 1, s = g & 1; src = KHT + (32 * t + r) * 72 + 32 * mt + 16 * s + 4 * hh; }
            else { const int g = f - 48, mt = g >> 2, mj = (g >> 1) & 1, s = g & 1; src = AQK + (32 * mt + r) * 72 + 32 * mj + 16 * s + 4 * hh; }
            const v2u lo = *(const LAS v2u*)src, hi2 = *(const LAS v2u*)(src + 8);
            *(GAS v4u*)(FR + ((size_t)i * 64 + C.lane) * 8) = (v4u){lo.x, lo.y, hi2.x, hi2.y}; }
    }
    __syncthreads();
}
__device__ __forceinline__ v4u pack8(const f32x16& a, int s) {
    v4u o; o.x = pk2(a[8 * s + 0], a[8 * s + 1]); o.y = pk2(a[8 * s + 2], a[8 * s + 3]); o.z = pk2(a[8 * s + 4], a[8 * s + 5]); o.w = pk2(a[8 * s + 6], a[8 * s + 7]); return o;
}
__device__ __forceinline__ void gdn_c2_wave(const Ctx& C, int bh, int slice, float* Oall) {
    const int b = bh >> 3, h = bh & 7; const int col = C.lane & 31, hh = C.lane >> 5;
    f32x16 S[4];
#pragma unroll
    for (int t = 0; t < 4; ++t)
#pragma unroll
        for (int r = 0; r < 16; ++r) S[t][r] = 0.f;
    const __amdgpu_buffer_rsrc_t rF = __builtin_amdgcn_make_buffer_rsrc((void*)((bf16*)(C.ws + WS_GDN_FR) + (size_t)bh * 128 * 28672), 0, 128 * 57344, 0x00020000);
    const __amdgpu_buffer_rsrc_t rU = __builtin_amdgcn_make_buffer_rsrc((void*)((float*)(C.ws + WS_GDN_UT) + (size_t)bh * 128 * 128 * 64), 0, 128 * 128 * 64 * 4, 0x00020000);
    const __amdgpu_buffer_rsrc_t rO = __builtin_amdgcn_make_buffer_rsrc((void*)(Oall + (size_t)b * T * 1024), 0, T * 1024 * 4, 0x00020000);
    const float* DLb = (const float*)(C.ws + WS_GDN_DL) + (size_t)bh * 128;
    const int vF = C.lane * 16, vU = ((slice * 32 + col) * 64 + 4 * hh) * 4, vO = (h * 128 + slice * 32 + col) * 4 + hh * 4 * 4096;
    constexpr int GW = 14, NSL = 56;
    bf16x8 win[GW]; f32x4 ur[2][4];
#define FLOAD(off) __builtin_bit_cast(bf16x8, __builtin_amdgcn_raw_buffer_load_b128(rF, vF, (off), 0))
#define ULOAD(su, mt, q) __builtin_bit_cast(f32x4, __builtin_amdgcn_raw_buffer_load_b128(rU, vU, (su) + (32 * (mt) + 8 * (q)) * 4, 0))
#pragma unroll
    for (int i = 0; i < GW; ++i) win[i] = FLOAD(i * 1024);
#pragma unroll
    for (int mt = 0; mt < 2; ++mt)
#pragma unroll
        for (int q = 0; q < 4; ++q) ur[mt][q] = ULOAD(0, mt, q);
    for (int c = 0; c < 128; ++c) {
        const int cn = c < 127 ? c + 1 : 127; const int sF = c * 57344, sFn = cn * 57344, sUn = cn * 32768, sO = c * 64 * 4096;
#define NEXTF(i) ({ const bf16x8 r_ = win[(i) % GW]; win[(i) % GW] = FLOAD(((i) + GW < NSL) ? sF + ((i) + GW) * 1024 : sFn + ((i) + GW - NSL) * 1024); r_; })
        bf16x8 Sb[4][2];
#pragma unroll
        for (int t = 0; t < 4; ++t)
#pragma unroll
            for (int s = 0; s < 2; ++s) Sb[t][s] = __builtin_bit_cast(bf16x8, pack8(S[t], s));
        bf16x8 Db[2][2];
#pragma unroll
        for (int mt = 0; mt < 2; ++mt) { f32x16 dl;
#pragma unroll
            for (int r = 0; r < 16; ++r) dl[r] = 0.f;
#pragma unroll
            for (int t = 0; t < 4; ++t)
#pragma unroll
                for (int s = 0; s < 2; ++s) dl = MFMA32(NEXTF(mt * 8 + t * 2 + s), Sb[t][s], dl);
#pragma unroll
            for (int q = 0; q < 4; ++q) { const f32x4 u = ur[mt][q]; ur[mt][q] = ULOAD(sUn, mt, q);
                dl[4 * q + 0] = u.x - dl[4 * q + 0]; dl[4 * q + 1] = u.y - dl[4 * q + 1]; dl[4 * q + 2] = u.z - dl[4 * q + 2]; dl[4 * q + 3] = u.w - dl[4 * q + 3]; }
#pragma unroll
            for (int s = 0; s < 2; ++s) Db[mt][s] = __builtin_bit_cast(bf16x8, pack8(dl, s));
        }
#pragma unroll
        for (int t = 0; t < 4; ++t)
#pragma unroll
            for (int r = 0; r < 16; ++r) asm volatile("" : "+v"(S[t][r]));
#pragma unroll
        for (int t = 0; t < 4; ++t)
#pragma unroll
            for (int s = 0; s < 2; ++s) Sb[t][s] = __builtin_bit_cast(bf16x8, pack8(S[t], s));
#pragma unroll
        for (int mt = 0; mt < 2; ++mt) { f32x16 o;
#pragma unroll
            for (int r = 0; r < 16; ++r) o[r] = 0.f;
#pragma unroll
            for (int t = 0; t < 4; ++t)
#pragma unroll
                for (int s = 0; s < 2; ++s) o = MFMA32(NEXTF((mt == 0 ? 16 : 26) + t * 2 + s), Sb[t][s], o);
#pragma unroll
            for (int mj = 0; mj <= mt; ++mj)
#pragma unroll
                for (int s = 0; s < 2; ++s) o = MFMA32(NEXTF((mt == 0 ? 24 : 34) + mj * 2 + s), Db[mj][s], o);
#pragma unroll
            for (int r = 0; r < 16; ++r) __builtin_amdgcn_raw_buffer_store_b32(__float_as_uint(o[r]), rO, vO, sO + (32 * mt + (r & 3) + 8 * (r >> 2)) * 4096, 0);
        }
        const float dlast = DLb[c];
#pragma unroll
        for (int t = 0; t < 4; ++t) {
#pragma unroll
            for (int r = 0; r < 16; ++r) S[t][r] *= dlast;
#pragma unroll
            for (int mt = 0; mt < 2; ++mt)
#pragma unroll
                for (int s = 0; s < 2; ++s) S[t] = MFMA32(NEXTF(38 + t * 4 + mt * 2 + s), Db[mt][s], S[t]);
        }
        (void)NEXTF(54); (void)NEXTF(55);
#undef NEXTF
    }
#undef FLOAD
#undef ULOAD
}
__device__ __forceinline__ void gdn_c3(const Ctx& C, const bf16* Z, bf16* MIX, const float* ng) {
    const float* O = (const float*)(C.ws + WS_GDN_O);
    const size_t NIT = (size_t)M * 8 * 16, STR = (size_t)C.G * NTHREADS;
    constexpr int U = 4;
    const int dg = C.tid & 15; const f32x4 g0 = *(const GAS f32x4*)(ng + dg * 8), g1 = *(const GAS f32x4*)(ng + dg * 8 + 4);
    for (size_t e0 = (size_t)C.bid * NTHREADS + C.tid; e0 < NIT; e0 += U * STR) {
        f32x4 o0[U], o1[U]; v4u gv[U]; bool ok[U]; size_t ob[U];
#pragma unroll
        for (int k = 0; k < U; ++k) { const size_t e = e0 + k * STR; ok[k] = e < NIT; const size_t ec = ok[k] ? e : e0; const int h = (int)((ec >> 4) & 7); const size_t m = ec >> 7;
            ob[k] = m * D + MX_C + h * 128 + dg * 8;
            o0[k] = *(const GAS f32x4*)(O + m * 1024 + h * 128 + dg * 8); o1[k] = *(const GAS f32x4*)(O + m * 1024 + h * 128 + dg * 8 + 4); gv[k] = *(const GAS v4u*)(Z + m * LDZ + ZC_G + h * 128 + dg * 8); }
#pragma unroll
        for (int k = 0; k < U; ++k) { const f32x4 a0 = o0[k], a1 = o1[k]; const v4u g = gv[k];
            float s = (a0.x * a0.x + a0.y * a0.y) + (a0.z * a0.z + a0.w * a0.w) + (a1.x * a1.x + a1.y * a1.y) + (a1.z * a1.z + a1.w * a1.w);
            s += __shfl_xor(s, 1); s += __shfl_xor(s, 2); s += __shfl_xor(s, 4); s += __shfl_xor(s, 8);
            const float rstd = 1.f / sqrtf(s * (1.f / 128.f) + NORM_EPS);
            v4u w; w.x = pk2(a0.x * rstd * g0.x * siluf(bflo(g.x)), a0.y * rstd * g0.y * siluf(bfhi(g.x))); w.y = pk2(a0.z * rstd * g0.z * siluf(bflo(g.y)), a0.w * rstd * g0.w * siluf(bfhi(g.y)));
            w.z = pk2(a1.x * rstd * g1.x * siluf(bflo(g.z)), a1.y * rstd * g1.y * siluf(bfhi(g.z))); w.w = pk2(a1.z * rstd * g1.z * siluf(bflo(g.w)), a1.w * rstd * g1.w * siluf(bfhi(g.w)));
            if (ok[k]) *(GAS v4u*)(MIX + ob[k]) = w; }
    }
}
__device__ __forceinline__ int rope_slot_col(int s) { return s < 8 ? ZA_Q + 128 * s : s < 10 ? ZA_K + 128 * (s - 8) : s < 14 ? ZA_IQ + 128 * (s - 10) : s < 15 ? ZA_IK : s < 23 ? ZD_Q + 128 * (s - 15) : ZD_K + 128 * (s - 23); }
__device__ __forceinline__ void rope_phase(const Ctx& C, bf16* Z, long zd, long ikd, int w0, int nw) {
    const f32x4* rope = (const f32x4*)(C.ws + WS_ROPE);
    const size_t NIT = (size_t)M * 31 * 8, STR = (size_t)nw * NTHREADS;
    constexpr int U = 4;
    for (size_t e0 = (size_t)(C.bid - w0) * NTHREADS + C.tid; e0 < NIT; e0 += U * STR) {
        v4u a[U], bq[U]; f32x4 cs[U][4]; bf16* zp[U]; int sl[U], pp[U]; size_t mm[U]; bool ok[U];
#pragma unroll
        for (int k = 0; k < U; ++k) { const size_t e = e0 + k * STR; ok[k] = e < NIT; const size_t ec = ok[k] ? e : e0;
            const int p = (int)(ec & 7); const size_t ms = ec >> 3; const int s = (int)(ms % 31); const size_t m = ms / 31; const int t = (int)(m & (T - 1));
            pp[k] = p; sl[k] = s; mm[k] = m; zp[k] = Z + m * LDZ + rope_slot_col(s) + 8 * p;
            a[k] = *(const GAS v4u*)zp[k]; bq[k] = *(const GAS v4u*)(zp[k] + 64);
#pragma unroll
            for (int q = 0; q < 4; ++q) cs[k][q] = rope[(size_t)t * 32 + 4 * p + q]; }
#pragma unroll
        for (int k = 0; k < U; ++k) { if (!ok[k]) continue;
            const unsigned aw[4] = {a[k].x, a[k].y, a[k].z, a[k].w}, bw[4] = {bq[k].x, bq[k].y, bq[k].z, bq[k].w}; unsigned o1[4], o2[4];
#pragma unroll
            for (int q = 0; q < 4; ++q) { const f32x4 c4 = cs[k][q]; const float x1a = bflo(aw[q]), x1b = bfhi(aw[q]), x2a = bflo(bw[q]), x2b = bfhi(bw[q]);
                o1[q] = pk2(x1a * c4.x - x2a * c4.y, x1b * c4.z - x2b * c4.w); o2[q] = pk2(x2a * c4.x + x1a * c4.y, x2b * c4.z + x1b * c4.w); }
            *(GAS v4u*)(zp[k] + zd) = (v4u){o1[0], o1[1], o1[2], o1[3]}; *(GAS v4u*)(zp[k] + zd + 64) = (v4u){o2[0], o2[1], o2[2], o2[3]};
            if (sl[k] == 14) {
                const size_t m = mm[k]; const int p = pp[k];
                bf16* ikp = (bf16*)(C.ws + WS_IK) + ikd + (((m >> 4) * 4 + (p >> 2)) * 64 + (p & 3) * 16 + (m & 15)) * 8; *(GAS v4u*)ikp = (v4u){o1[0], o1[1], o1[2], o1[3]}; *(GAS v4u*)(ikp + 2 * 512) = (v4u){o2[0], o2[1], o2[2], o2[3]}; } }
    }
}
__device__ __forceinline__ void vt_unit(const Ctx& C, const bf16* Z, int unit) {
    const int tt = unit & 127, s = (unit >> 7) % 10, b = (unit >> 7) / 10;
    LAS bf16* TL = (LAS bf16*)C.lds;
    const int zc = s < 2 ? ZA_V + 128 * s : ZD_V + 128 * (s - 2);
    bf16* dst = s < 2 ? (bf16*)(C.ws + WS_VTA) + ((size_t)(b * 2 + s) * 128) * T : (bf16*)(C.ws + WS_VTD) + ((size_t)(b * 8 + (s - 2)) * 128) * T;
    __syncthreads();
    for (int e = C.tid; e < 1024; e += NTHREADS) { const int j = e >> 4, pc = e & 15; *(LAS v4u*)(TL + j * 136 + pc * 8) = *(const GAS v4u*)(Z + ((size_t)b * T + tt * 64 + j) * LDZ + zc + pc * 8); }
    __syncthreads();
    for (int e = C.tid; e < 1024; e += NTHREADS) { const int d = e >> 3, tg = e & 7; unsigned w[4];
#pragma unroll
        for (int q = 0; q < 4; ++q) { const int g4 = (tg & 1) * 2 + (q >> 1), kg4 = (g4 == 1) ? 2 : (g4 == 2) ? 1 : g4, j = (tg >> 1) * 16 + kg4 * 4 + (2 * q & 3);
            w[q] = (unsigned)TL[j * 136 + d] | ((unsigned)TL[(j + 1) * 136 + d] << 16); }
        *(GAS v4u*)(dst + (size_t)d * T + tt * 64 + tg * 8) = (v4u){w[0], w[1], w[2], w[3]}; }
    __syncthreads();
}
__device__ __forceinline__ void kmean_unit(const Ctx& C, const bf16* Z, int unit) {
    const int blk = unit & 31, h = (unit >> 5) & 7, b = unit >> 8;
    LAS float* PS = (LAS float*)C.lds;
    const int dg = C.tid & 15, tg = C.tid >> 4; float s[8];
#pragma unroll
    for (int q = 0; q < 8; ++q) s[q] = 0.f;
#pragma unroll
    for (int j = 0; j < 8; ++j) { const v4u kv = *(const GAS v4u*)(Z + ((size_t)b * T + blk * 256 + tg * 8 + j) * LDZ + ZD_K + h * 128 + dg * 8);
        s[0] += bflo(kv.x); s[1] += bfhi(kv.x); s[2] += bflo(kv.y); s[3] += bfhi(kv.y); s[4] += bflo(kv.z); s[5] += bfhi(kv.z); s[6] += bflo(kv.w); s[7] += bfhi(kv.w); }
    __syncthreads();
#pragma unroll
    for (int q = 0; q < 8; ++q) PS[tg * 128 + dg * 8 + q] = s[q];
    __syncthreads();
    if (C.tid < 128) { float a = 0.f;
#pragma unroll
        for (int g = 0; g < 32; ++g) a += PS[g * 128 + C.tid];
        ((bf16*)(C.ws + WS_KMEAN))[(size_t)unit * 128 + C.tid] = (bf16)f2bf(a * (1.f / 256.f)); }
    __syncthreads();
}
constexpr int A1_SC = 0, A1_HIST = 131072, A1_MSK = 147456, A1_CV = 151552, A1_CI = 152576, A1_MM = 153600, A1_NLH = 153856, A1_FLAG = 153920;
constexpr int DSA_K = 256, A1_NBIN = 1024;
__device__ __forceinline__ unsigned lane_prefix(unsigned long long m) { return __builtin_amdgcn_mbcnt_hi((unsigned)(m >> 32), __builtin_amdgcn_mbcnt_lo((unsigned)m, 0u)); }
__device__ __forceinline__ int sel_bin(float v, float lo, float scale) { const float d = v - lo; return d <= 0.f ? 1 : 1 + (int)fminf(d * scale, (float)(A1_NBIN - 2)); }
__device__ __forceinline__ int sel_bin_m(float v, int i, int n, float lo, float hi, float scale) {
    const float d = v - lo; const int x = (int)fminf(d * scale, (float)(A1_NBIN - 2)); const int bn = (d > 0.f) ? 1 + x : 1;
    const bool inr = (i < n) & (v >= lo) & (v <= hi); return inr ? bn : 0; }
#define A1_LD8(dst, base_) do { _Pragma("unroll") for (int u_ = 0; u_ < 8; ++u_) dst[u_] = s[(base_) + 64 * u_ + lane]; } while (0)
template <bool SMALL> __device__ __forceinline__ void a1_pass2_step(const float (&v8)[8], int base, int n, float lo, float hi, float scale, int bstar, int lane, int lu, unsigned long long& M,
                                                                    LAS float* cv, LAS unsigned* ci, int& cnt, int cdir, float& nlo, float& nhi) {
    int b8[8];
#pragma unroll
    for (int u = 0; u < 8; ++u) b8[u] = sel_bin_m(v8[u], base + 64 * u + lane, n, lo, hi, scale);
#pragma unroll
    for (int u = 0; u < 8; ++u) {
        const unsigned long long sb = __ballot(b8[u] > bstar);
        M = (lu == u) ? (M | sb) : M;
        const bool isc = b8[u] == bstar;
        if (SMALL) { const unsigned long long cb = __ballot(isc);
            if (cb) { if (isc) { const int pos = cnt + cdir * (int)lane_prefix(cb); cv[pos] = v8[u]; ci[pos] = (unsigned)(base + 64 * u + lane); } cnt += cdir * __popcll(cb); } }
        else { nlo = isc ? fminf(nlo, v8[u]) : nlo; nhi = isc ? fmaxf(nhi, v8[u]) : nhi; }
    }
}
__device__ __forceinline__ void dsa_select_block(const Ctx& C, int t0) {
    const int lane = C.lane, r = C.wave >> 1, hf = C.wave & 1, n = t0 + r + 1;
    const LAS float* s = (const LAS float*)(C.lds + A1_SC) + r * 8192;
    LAS unsigned* hist = (LAS unsigned*)(C.lds + A1_HIST) + r * A1_NBIN; LAS unsigned* msk = (LAS unsigned*)(C.lds + A1_MSK) + r * 256;
    LAS float* cv = (LAS float*)(C.lds + A1_CV) + r * 64; LAS unsigned* ci = (LAS unsigned*)(C.lds + A1_CI) + r * 64;
    LAS float* MM = (LAS float*)(C.lds + A1_MM); LAS float* NLH = (LAS float*)(C.lds + A1_NLH); volatile LAS unsigned* FL = (volatile LAS unsigned*)(C.lds + A1_FLAG);
    const float PINF = __builtin_inff();
    float lo = MM[r * 2], hi = MM[r * 2 + 1];
#pragma unroll
    for (int w = 1; w < NWAVES; ++w) { lo = fminf(lo, MM[(w * 4 + r) * 2]); hi = fmaxf(hi, MM[(w * 4 + r) * 2 + 1]); }
    bool active = n > DSA_K; bool dorank = false;
    int need = DSA_K, ncand = 0;
    unsigned long long mA = 0ull, mB = 0ull;
    *(LAS v2u*)(msk + hf * 128 + 2 * lane) = (v2u){0u, 0u};
    if (C.tid < 2) FL[C.tid] = 0u;
    const int nstep = (n + 511) >> 9;
    for (int iter = 0; iter < 64; ++iter) {
        __syncthreads();
        if (active && lane == 0) FL[iter & 1] = 1u;
        __syncthreads();
        const bool any = FL[iter & 1] != 0u;
        if (C.tid == 0) FL[(iter + 1) & 1] = 0u;
        if (!any) break;
        if (active && lo == hi) {
            if (hf == 0) { int running = 0;
                for (int base = 0; base < n && running < need; base += 64) { const int i = base + lane; const bool cnd = (i < n) && (s[i] == lo);
                    const unsigned long long bal = __ballot(cnd); const bool sel = cnd && (running + (int)lane_prefix(bal) < need);
                    const unsigned long long sb = __ballot(sel); const int ch = base >> 6;
                    if (lane == (ch & 63)) { if (ch < 64) mA |= sb; else mB |= sb; }
                    running += __popcll(bal); } }
            need = 0; active = false;
        }
        if (active) {
#pragma unroll
            for (int q = 0; q < 2; ++q) *(LAS v4u*)(hist + hf * 512 + 256 * q + 4 * lane) = (v4u){0u, 0u, 0u, 0u}; }
        __syncthreads();
        const float scale = (float)(A1_NBIN - 1) / (hi - lo);
        if (active) { float v8[8]; A1_LD8(v8, hf * 512);
            for (int st = hf; st < nstep; st += 2) { const int base = st * 512;
                float nx[8]; A1_LD8(nx, (st + 2 < nstep ? st + 2 : st) * 512);
#pragma unroll
                for (int u = 0; u < 8; ++u) asm volatile("" : "+v"(v8[u]));
#pragma unroll
                for (int u = 0; u < 8; ++u) { const int bn = sel_bin_m(v8[u], base + 64 * u + lane, n, lo, hi, scale);
                    __hip_atomic_fetch_add(hist + bn, 1u, __ATOMIC_RELAXED, __HIP_MEMORY_SCOPE_WORKGROUP); }
#pragma unroll
                for (int u = 0; u < 8; ++u) v8[u] = nx[u]; } }
        __syncthreads();
        int bstar = 1, cabove = 0, mcnt = 0; float nlo = PINF, nhi = -PINF;
        if (active) {
            unsigned hb[16]; unsigned mysum = 0;
#pragma unroll
            for (int q = 0; q < 4; ++q) { const v4u h4 = *(const LAS v4u*)(hist + lane * 16 + q * 4); hb[4 * q] = h4.x; hb[4 * q + 1] = h4.y; hb[4 * q + 2] = h4.z; hb[4 * q + 3] = h4.w; mysum += h4.x + h4.y + h4.z + h4.w; }
            if (lane == 0) mysum -= hb[0];
            unsigned suf = mysum;
#pragma unroll
            for (int o = 1; o < 64; o <<= 1) { const unsigned nb = __shfl_down(suf, o); if (lane + o < 64) suf += nb; }
            const unsigned long long okm = __ballot(suf >= (unsigned)need);
            const int L = okm ? 63 - __builtin_clzll(okm) : 0;
            if (lane == L) { unsigned a = suf - mysum;
#pragma unroll
                for (int q = 15; q >= 0; --q) { if (mcnt == 0 && (lane > 0 || q > 0)) { if (a + hb[q] >= (unsigned)need) { bstar = lane * 16 + q; cabove = (int)a; mcnt = (int)hb[q]; } else a += hb[q]; } } }
            bstar = __shfl(bstar, L); cabove = __shfl(cabove, L); mcnt = __shfl(mcnt, L);
            int cnt = hf ? mcnt - 1 : 0; const int cdir = hf ? -1 : 1;
            float v8[8]; A1_LD8(v8, hf * 512);
            for (int st = hf; st < nstep; st += 2) { const int base = st * 512; const int lu = lane - 8 * (st & 7);
                float nx[8]; A1_LD8(nx, (st + 2 < nstep ? st + 2 : st) * 512);
#pragma unroll
                for (int u = 0; u < 8; ++u) asm volatile("" : "+v"(v8[u]));
                if (st < 8) { if (mcnt <= 64) a1_pass2_step<true>(v8, base, n, lo, hi, scale, bstar, lane, lu, mA, cv, ci, cnt, cdir, nlo, nhi); else a1_pass2_step<false>(v8, base, n, lo, hi, scale, bstar, lane, lu, mA, cv, ci, cnt, cdir, nlo, nhi); }
                else        { if (mcnt <= 64) a1_pass2_step<true>(v8, base, n, lo, hi, scale, bstar, lane, lu, mB, cv, ci, cnt, cdir, nlo, nhi); else a1_pass2_step<false>(v8, base, n, lo, hi, scale, bstar, lane, lu, mB, cv, ci, cnt, cdir, nlo, nhi); }
#pragma unroll
                for (int u = 0; u < 8; ++u) v8[u] = nx[u]; }
            if (mcnt > 64) { nlo = wave_min(nlo); nhi = wave_max(nhi); if (lane == 0) { NLH[C.wave * 2] = nlo; NLH[C.wave * 2 + 1] = nhi; } }
        }
        __syncthreads();
        if (active) { need -= cabove;
            if (mcnt <= 64) { ncand = mcnt; dorank = true; active = false; }
            else { lo = fminf(NLH[4 * r], NLH[4 * r + 2]); hi = fmaxf(NLH[4 * r + 1], NLH[4 * r + 3]); } }
    }
    { __hip_atomic_fetch_or(msk + 2 * lane, (unsigned)mA, __ATOMIC_RELAXED, __HIP_MEMORY_SCOPE_WORKGROUP); __hip_atomic_fetch_or(msk + 2 * lane + 1, (unsigned)(mA >> 32), __ATOMIC_RELAXED, __HIP_MEMORY_SCOPE_WORKGROUP);
      __hip_atomic_fetch_or(msk + 128 + 2 * lane, (unsigned)mB, __ATOMIC_RELAXED, __HIP_MEMORY_SCOPE_WORKGROUP); __hip_atomic_fetch_or(msk + 128 + 2 * lane + 1, (unsigned)(mB >> 32), __ATOMIC_RELAXED, __HIP_MEMORY_SCOPE_WORKGROUP); }
    __syncthreads();
    if (hf == 0) {
        if (n <= DSA_K) { for (int w = lane; w < 256; w += 64) { const int rem = n - 32 * w; msk[w] = rem >= 32 ? 0xffffffffu : rem > 0 ? ((1u << rem) - 1u) : 0u; } }
        else if (dorank && ncand > 0) {
            const float vj = (lane < ncand) ? cv[lane] : 0.f; const unsigned ij = (lane < ncand) ? ci[lane] : 0u; int rank = 0;
            for (int k = 0; k < ncand; ++k) { const float vk = cv[k]; const unsigned ik = ci[k]; rank += (vk > vj || (vk == vj && ik < ij)) ? 1 : 0; }
            if (lane < ncand && rank < need) __hip_atomic_fetch_or(msk + (ij >> 5), 1u << (ij & 31), __ATOMIC_RELAXED, __HIP_MEMORY_SCOPE_WORKGROUP);
        }
    }
}
__device__ __forceinline__ void dsa_a1_unit(const Ctx& C, const bf16* Z, int unit, int pflags = 0) {
    const int b = unit >> 11, t0 = (2047 - (unit & 2047)) * 4;
    LAS float* SC = (LAS float*)(C.lds + A1_SC); LAS float* MM = (LAS float*)(C.lds + A1_MM);
    const int nk = t0 + 4, ntile = (nk + 15) >> 4;
    const int row = C.lane & 15, kg = C.lane >> 4;
    bf16x8 af[4];
    { const bf16* qp = Z + ((size_t)b * T + t0 + (row >> 2)) * LDZ + ZA_IQ + (row & 3) * 128 + kg * 8;
#pragma unroll
      for (int ks = 0; ks < 4; ++ks) af[ks] = *(const GAS bf16x8*)(qp + ks * 32); }
    float wv[4];
    { const bf16* wp = Z + ((size_t)b * T + t0 + kg) * LDZ + ZS_IW;
#pragma unroll
      for (int r = 0; r < 4; ++r) wv[r] = bf2f(wp[r]); }
    const bf16* IKb = (const bf16*)(C.ws + WS_IK) + (size_t)b * T * 128 + C.lane * 8;
    float lmin = __builtin_inff(), lmax = -__builtin_inff(); const int qn = t0 + kg;
    __syncthreads();
    if (!(pflags & 2)) for (int kt0 = C.wave; kt0 < ntile; kt0 += 8 * NWAVES) {
        bf16x8 bfr[8][4];
#pragma unroll
        for (int j = 0; j < 8; ++j) { int kt = kt0 + j * NWAVES; kt = kt < ntile ? kt : ntile - 1;
#pragma unroll
            for (int ks = 0; ks < 4; ++ks) bfr[j][ks] = *(const GAS bf16x8*)(IKb + (size_t)kt * 2048 + ks * 512); }
#pragma unroll
        for (int j = 0; j < 8; ++j) { const int kt = kt0 + j * NWAVES;
            f32x4 acc = (f32x4){0.f, 0.f, 0.f, 0.f};
#pragma unroll
            for (int ks = 0; ks < 4; ++ks) acc = MFMA16(af[ks], bfr[j][ks], acc);
            const float sc = wv[0] * fmaxf(acc[0], 0.f) + wv[1] * fmaxf(acc[1], 0.f) + wv[2] * fmaxf(acc[2], 0.f) + wv[3] * fmaxf(acc[3], 0.f);
            if (kt < ntile) SC[kg * 8192 + kt * 16 + row] = sc;
            const bool vld = kt * 16 + row <= qn;
            lmin = vld ? fminf(lmin, sc) : lmin; lmax = vld ? fmaxf(lmax, sc) : lmax; }
    }
#pragma unroll
    for (int o = 1; o < 16; o <<= 1) { lmin = fminf(lmin, __shfl_xor(lmin, o)); lmax = fmaxf(lmax, __shfl_xor(lmax, o)); }
    if (row == 0) { MM[(C.wave * 4 + kg) * 2] = lmin; MM[(C.wave * 4 + kg) * 2 + 1] = lmax; }
    __syncthreads();
    if (!(pflags & 1)) dsa_select_block(C, t0);
    __syncthreads();
    if (C.tid < 256 && pflags == 0) { const LAS unsigned* MK = (const LAS unsigned*)(C.lds + A1_MSK);
        *(GAS v4u*)((unsigned*)(C.ws + WS_MASK) + ((size_t)b * 256 + C.tid) * T + t0) = (v4u){MK[C.tid], MK[256 + C.tid], MK[512 + C.tid], MK[768 + C.tid]}; }
}
#undef A1_LD8
constexpr int AT_KT = 0, AT_VT = 17408, AT_STAGE = 35840, AT_UNION = 2 * AT_STAGE;
template <int MODE>
__device__ __forceinline__ void attn_unit(const Ctx& C, const bf16* Z, bf16* MIX, int unit) {
    const int qt = 31 - (unit & 31), h = (unit >> 5) & 7, b = unit >> 8;
    int lane_o = C.lane, tid_o = C.tid; asm volatile("" : "+v"(lane_o), "+v"(tid_o));
    const int q0 = qt * 256; const int col = lane_o & 31, hh = lane_o >> 5;
    const int tq = q0 + C.wave * 32 + col;
    const size_t mq = (size_t)b * T + tq;
    const int zq = (MODE == 0 ? ZA_Q : ZD_Q) + h * 128, zk = (MODE == 0 ? ZA_K + (h >> 2) * 128 : ZD_K + h * 128);
    const bf16* VTg = (MODE == 0) ? (const bf16*)(C.ws + WS_VTA) + ((size_t)(b * 2 + (h >> 2)) * 128) * T : (const bf16*)(C.ws + WS_VTD) + ((size_t)(b * 8 + h) * 128) * T;
    bf16x8 Qf[8];
#pragma unroll
    for (int ks = 0; ks < 8; ++ks) Qf[ks] = *(const GAS bf16x8*)(Z + mq * LDZ + zq + ks * 16 + hh * 8);
    unsigned selmask = 0u; unsigned uni = 0xffffffffu;
    __syncthreads();
    if (MODE == 1) {
        LAS unsigned* UN = (LAS unsigned*)(C.lds + AT_UNION);
        if (C.tid == 0) *UN = 0u;
        const bf16* KM = (const bf16*)(C.ws + WS_KMEAN) + ((size_t)(b * 8 + h) * 32) * 128;
        f32x16 g;
#pragma unroll
        for (int r = 0; r < 16; ++r) g[r] = 0.f;
#pragma unroll
        for (int ks = 0; ks < 8; ++ks) g = MFMA32(*(const GAS bf16x8*)(KM + (size_t)col * 128 + ks * 16 + hh * 8), Qf[ks], g);
        const int nsel = qt < 3 ? qt : 3;
        for (int it = 0; it < nsel; ++it) { float bv = -__builtin_inff(); int bi = 64;
#pragma unroll
            for (int r = 0; r < 16; ++r) { const int blk = (r & 3) + 8 * (r >> 2) + 4 * hh; const bool ok = blk < qt && !((selmask >> blk) & 1u);
                if (ok && (g[r] > bv || (g[r] == bv && blk < bi))) { bv = g[r]; bi = blk; } }
            const float ov = __shfl_xor(bv, 32); const int oi = __shfl_xor(bi, 32);
            if (ov > bv || (ov == bv && oi < bi)) { bv = ov; bi = oi; }
            if (bi < 32) selmask |= 1u << bi; }
        unsigned um = selmask;
#pragma unroll
        for (int o = 1; o < 32; o <<= 1) um |= __shfl_xor(um, o);
        __syncthreads();
        if (C.lane == 0) __hip_atomic_fetch_or(UN, um, __ATOMIC_RELAXED, __HIP_MEMORY_SCOPE_WORKGROUP);
        __syncthreads();
        uni = *UN | (1u << qt);
    }
    const unsigned* MK = (const unsigned*)(C.ws + WS_MASK) + (size_t)b * 256 * T + tq;
    f32x16 O[4];
#pragma unroll
    for (int dt = 0; dt < 4; ++dt)
#pragma unroll
        for (int r = 0; r < 16; ++r) O[dt][r] = 0.f;
    float mrun = -1e30f, lrun = 0.f;
    const float SCL = 0.08838834764831845f * 1.4426950408889634f;
    const int ntile = 4 * (qt + 1);
    v4u kreg[2], vreg[2];
#define ldtile(KT_) do { _Pragma("unroll") for (int i_ = 0; i_ < 2; ++i_) { const int e_ = tid_o + i_ * NTHREADS; \
            kreg[i_] = *(const GAS v4u*)(Z + ((size_t)b * T + (KT_) * 64 + (e_ >> 4)) * LDZ + zk + (e_ & 15) * 8); \
            vreg[i_] = *(const GAS v4u*)(VTg + (size_t)(e_ >> 3) * T + (KT_) * 64 + (e_ & 7) * 8); } } while (0)
#define sttile(ST_) do { _Pragma("unroll") for (int i_ = 0; i_ < 2; ++i_) { const int e_ = tid_o + i_ * NTHREADS; \
            *(LAS v4u*)(C.lds + (ST_) * AT_STAGE + AT_KT + ((e_ >> 4) * 136 + (e_ & 15) * 8) * 2) = kreg[i_]; \
            *(LAS v4u*)(C.lds + (ST_) * AT_STAGE + AT_VT + ((e_ >> 3) * 72 + (e_ & 7) * 8) * 2) = vreg[i_]; } } while (0)
    int kt = 0;
    while (kt < ntile && !((uni >> (kt >> 2)) & 1u)) ++kt;
    unsigned mwn[2] = {0xffffffffu, 0xffffffffu};
    if (kt < ntile) { if (MODE == 0) { mwn[0] = MK[(size_t)(kt * 2) * T]; mwn[1] = MK[(size_t)(kt * 2 + 1) * T]; } ldtile(kt); sttile(0); }
    __syncthreads();
    int st = 0;
    while (kt < ntile) {
        int kn = kt + 1;
        while (kn < ntile && !((uni >> (kn >> 2)) & 1u)) ++kn;
        const unsigned mw[2] = {mwn[0], mwn[1]};
        if (kn < ntile) { if (MODE == 0) { mwn[0] = MK[(size_t)(kn * 2) * T]; mwn[1] = MK[(size_t)(kn * 2 + 1) * T]; } ldtile(kn); }
        const LAS bf16* Ks = (const LAS bf16*)(C.lds + st * AT_STAGE + AT_KT); const LAS bf16* Vs = (const LAS bf16*)(C.lds + st * AT_STAGE + AT_VT);
        f32x16 S2[2];
#pragma unroll
        for (int kk = 0; kk < 2; ++kk) {
#pragma unroll
            for (int r = 0; r < 16; ++r) S2[kk][r] = 0.f;
#pragma unroll
            for (int ks = 0; ks < 8; ++ks) S2[kk] = MFMA32(*(const LAS bf16x8*)(Ks + (kk * 32 + col) * 136 + ks * 16 + hh * 8), Qf[ks], S2[kk]);
            asm volatile("" ::: "memory");
        }
        float mloc = -__builtin_inff();
        const int blk = kt >> 2;
#pragma unroll
        for (int kk = 0; kk < 2; ++kk)
#pragma unroll
            for (int r = 0; r < 16; ++r) { const int kin = (r & 3) + 8 * (r >> 2) + 4 * hh;
                bool ok;
                if (MODE == 0) ok = (mw[kk] >> kin) & 1u;
                else ok = (blk == qt) ? (kt * 64 + kk * 32 + kin <= tq) : ((selmask >> blk) & 1u);
                const float v = ok ? S2[kk][r] : -__builtin_inff(); S2[kk][r] = v; mloc = fmaxf(mloc, v); }
        mloc = fmaxf(mloc, __shfl_xor(mloc, 32)) * SCL;
        const float mnew = fmaxf(mrun, mloc); const float alpha = exp2f(mrun - mnew); mrun = mnew;
        float ls = 0.f;
#pragma unroll
        for (int kk = 0; kk < 2; ++kk)
#pragma unroll
            for (int r = 0; r < 16; ++r) { const float p = exp2f(__builtin_fmaf(S2[kk][r], SCL, -mnew)); S2[kk][r] = p; ls += p; }
        lrun = lrun * alpha + ls;
        if (__any(alpha != 1.f)) {
#pragma unroll
            for (int dt = 0; dt < 4; ++dt)
#pragma unroll
                for (int r = 0; r < 16; ++r) O[dt][r] *= alpha; }
        bf16x8 Pb[2][2];
#pragma unroll
        for (int kk = 0; kk < 2; ++kk)
#pragma unroll
            for (int s = 0; s < 2; ++s) Pb[kk][s] = __builtin_bit_cast(bf16x8, pack8(S2[kk], s));
#pragma unroll
        for (int dt = 0; dt < 4; ++dt)
#pragma unroll
            for (int kk = 0; kk < 2; ++kk)
#pragma unroll
                for (int s = 0; s < 2; ++s) {
                    O[dt] = MFMA32(*(const LAS bf16x8*)(Vs + (dt * 32 + col) * 72 + kk * 32 + s * 16 + hh * 8), Pb[kk][s], O[dt]); if (kk == 1 && s == 1 && (dt & 1)) asm volatile("" ::: "memory"); }
        if (kn < ntile) sttile(st ^ 1);
        __syncthreads();
        st ^= 1; kt = kn;
    }
    const float l = lrun + __shfl_xor(lrun, 32); const float il = 1.f / l;
    bf16* op = MIX + mq * D + (MODE == 0 ? MX_A : MX_D) + h * 128 + 4 * hh;
#pragma unroll
    for (int dt = 0; dt < 4; ++dt)
#pragma unroll
        for (int q = 0; q < 4; ++q) { v2u w; w.x = pk2(O[dt][4 * q] * il, O[dt][4 * q + 1] * il); w.y = pk2(O[dt][4 * q + 2] * il, O[dt][4 * q + 3] * il);
            *(GAS v2u*)(op + dt * 32 + 8 * q) = w; }
#undef ldtile
#undef sttile
    __syncthreads();
}
constexpr int SUB_A1 = 1, SUB_C1 = 2, SUB_B1 = 4, SUB_KM = 8, SUB_C2 = 16, SUB_AT0 = 32, SUB_AT1 = 64, SUB_B2 = 128, SUB_ALL = 255, SUB_DUMMY = 256;
constexpr int N_PHASES = 1 + 10 * NLAYER;
#define IN(k) (lo <= (k) && (k) < hi)
#define SEAM(k) do { if (IN(k) && IN((k) + 1)) xcd_barrier(bar); } while (0)
template <int l> __device__ __forceinline__ void layer_body(const Ctx& C, const Args& args, const int lo, const int hi, const XcdBarrier& bar, gu32* ctl) {
    bf16* HB = (bf16*)(C.ws + WS_HB); bf16* Z = (bf16*)(C.ws + WS_Z); bf16* MIX = (bf16*)(C.ws + WS_MIX); bf16* FF = (bf16*)(C.ws + WS_FF);
    const bool dummy = (args.sub & SUB_DUMMY) != 0;
    const int pb = 1 + 10 * l;
    constexpr int NT_MAIN = 48, TAIL_WGS = M / 256;
    if (IN(pb + 0)) {
        pg8::Gemm g{HB, (const bf16*)(C.ws + WS_WIN + l * WIN_BYTES), M, LDZ, D}; pg8::StaticOrder S; S.init(M, (C.G > TAIL_WGS ? NT_MAIN : NT_MAIN + 1) * 256, C.G, C.bid);
        pg8::EpiStoreBf16 E{Z, LDZ};
        pg8::gemm_phase<pg8::EpiStoreBf16, pg8::StaticOrder, true, true>(C.lds, g, S, E);
    } SEAM(pb + 0);
    if (IN(pb + 1)) {
        if (C.bid < TAIL_WGS && C.G > TAIL_WGS) {
            pg8::Gemm g{HB, (const bf16*)(C.ws + WS_WIN + l * WIN_BYTES), M, LDZ, D}; pg8::ColumnOrder S{C.bid, TAIL_WGS, NT_MAIN};
            pg8::EpiStoreBf16 E{Z, LDZ};
            pg8::gemm_phase<pg8::EpiStoreBf16, pg8::ColumnOrder, true, true>(C.lds, g, S, E);
        } else {
            const int w0 = C.G > TAIL_WGS ? TAIL_WGS : 0, nw = C.G - w0;
            rope_phase(C, Z, dummy ? (long)((WS_SCR - WS_Z) / 2) : 0L, dummy ? (long)((WS_SCR + 400 * MiB - WS_IK) / 2) : 0L, w0, nw);
            for (int u = C.bid - w0; u < 2 * 10 * 128; u += nw) if ((u >> 7) % 10 != 9) vt_unit(C, Z, u);
        }
    } SEAM(pb + 1);
    if (IN(pb + 2)) {
        const float* w2 = args.in[7] + (size_t)l * 16 * 512; const float* gb = args.in[8] + (size_t)l * 512;
        const float* convw = args.in[10] + (size_t)l * 4 * 3072; const float* alog = args.in[11] + (size_t)l * 8; const float* dtb = args.in[12] + (size_t)l * 8;
        if (args.sub & SUB_KM) for (int u = C.bid; u < 256; u += C.G) vt_unit(C, Z, (u >> 7) * 1280 + 9 * 128 + (u & 127));
        if (args.sub & SUB_A1) { const bool serp = (4096 % C.G) == 0;
            for (int k = 0; k * C.G < 4096; ++k) { const int u = k * C.G + ((serp && (k & 1)) ? C.G - 1 - C.bid : C.bid); if (u < 4096) dsa_a1_unit(C, Z, u, (args.sub >> 9) & 3); } }
        if (args.sub & SUB_C1) for (int u = C.bid; u < 2048; u += C.G) gdn_c1_unit(C, Z, convw, alog, dtb, u);
        if (args.sub & SUB_B1) for (int u = C.bid; u < 1024; u += C.G) gla_b1_unit(C, Z, w2, gb, u);
        if (args.sub & SUB_KM) for (int u = C.bid; u < 512; u += C.G) kmean_unit(C, Z, u);
    } SEAM(pb + 2);
    if (IN(pb + 3)) {
        gu32* head = ctl + CW_QUEUE + 64 * 4 * l + 1024 * args.qrep;
        if (args.sub & SUB_C2) for (;;) { const int u = q_next(C, head); if (u >= 16) break; if (C.wave < 4) gdn_c2_wave(C, u, C.wave, (float*)(C.ws + WS_GDN_O)); }
        if (args.sub & SUB_B2) for (;;) { const int u = q_next(C, head + 192); if (u >= 128) break; gla_b2_unit(C, u); }
        if (args.sub & SUB_AT0) for (;;) { const int u = q_next(C, head + 64); if (u >= 512) break; attn_unit<0>(C, Z, MIX, (((u >> 3) & 1) << 8) | ((u & 7) << 5) | (u >> 4)); }
        if (args.sub & SUB_AT1) for (;;) { const int u = q_next(C, head + 128); if (u >= 512) break; attn_unit<1>(C, Z, MIX, (((u >> 3) & 1) << 8) | ((u & 7) << 5) | (u >> 4)); }
    } SEAM(pb + 3);
    if (IN(pb + 4)) {
        const float* w2 = args.in[7] + (size_t)l * 16 * 512; const float* gb = args.in[8] + (size_t)l * 512;
        for (int u = C.bid; u < 1024; u += C.G) gla_b3_unit(C, Z, MIX, w2, gb, args.in[9] + (size_t)l * 256, u);
        gdn_c3(C, Z, MIX, args.in[13] + (size_t)l * 128);
    } SEAM(pb + 4);
    float* const pdst = (float*)(C.ws + WS_SCR); bf16* const pdstb = (bf16*)(C.ws + WS_SCR + (size_t)M * D * 4); float* const pstat = (float*)(C.ws + WS_SCR + (size_t)M * D * 6);
    float* const stats = (float*)(C.ws + WS_STATS);
    if (IN(pb + 5)) {
        pg8::Gemm g{MIX, (const bf16*)(C.ws + WS_WOUT + l * WOUT_BYTES), M, D, D}; pg8::StaticOrder S; S.init(M, D, C.G, C.bid);
        pg8::EpiResidual E{l == 0 ? args.in[0] : C.out, dummy ? pdst : C.out, D, DN_ALPHA, stats, l == 0 ? args.in[1] : args.in[16] + (size_t)(l - 1) * D, l == 0 ? args.in[2] : args.in[17] + (size_t)(l - 1) * D};
        pg8::gemm_phase<pg8::EpiResidual, pg8::StaticOrder, true, true>(C.lds, g, S, E);
    } SEAM(pb + 5);
    if (IN(pb + 6)) { ln_phase(C, C.out, nullptr, dummy ? pdstb : HB, dummy ? pstat : stats, args.in[5] + (size_t)l * D, args.in[6] + (size_t)l * D); } SEAM(pb + 6);
    if (IN(pb + 7)) {
        pg8::Gemm g{HB, (const bf16*)(C.ws + WS_WUP + l * WUP_BYTES), M, DFF, D}; pg8::StaticOrder S; S.init(M, DFF, C.G, C.bid);
        pg8::EpiSqRelu E{FF, DFF};
        pg8::gemm_phase<pg8::EpiSqRelu, pg8::StaticOrder, true, true>(C.lds, g, S, E);
    } SEAM(pb + 7);
    if (IN(pb + 8)) {
        pg8::Gemm g{FF, (const bf16*)(C.ws + WS_WDN + l * WDN_BYTES), M, D, DFF}; pg8::StaticOrder S; S.init(M, D, C.G, C.bid);
        pg8::EpiResidual E{C.out, dummy ? pdst : C.out, D, DN_ALPHA, stats, args.in[5] + (size_t)l * D, args.in[6] + (size_t)l * D};
        pg8::gemm_phase<pg8::EpiResidual, pg8::StaticOrder, true, true>(C.lds, g, S, E);
    } SEAM(pb + 8);
    if (IN(pb + 9)) {
        if (l + 1 < NLAYER) ln_phase(C, C.out, nullptr, dummy ? pdstb : HB, dummy ? pstat : stats, args.in[16] + (size_t)l * D, args.in[17] + (size_t)l * D);
        else ln_phase(C, C.out, dummy ? pdst : C.out, nullptr, nullptr, args.in[16] + (size_t)l * D, args.in[17] + (size_t)l * D);
    }
    if (l + 1 < NLAYER) SEAM(pb + 9);
}
__global__ void __launch_bounds__(NTHREADS, 2) mk_fwd(Args args_byval) {
    const Args& args = *(const Args*)__builtin_amdgcn_kernarg_segment_ptr();
    extern __shared__ __attribute__((aligned(16))) unsigned char lds_raw[];
    Ctx C; C.lds = (LAS unsigned char*)lds_raw; C.tid = threadIdx.x; C.lane = C.tid & 63; C.wave = __builtin_amdgcn_readfirstlane(C.tid >> 6);
    C.bid = blockIdx.x; C.G = gridDim.x; C.ws = args.ws; C.out = args.out;
    gu32* ctl = (gu32*)(C.ws + WS_CTL);
    volatile LAS unsigned* MISC = (volatile LAS unsigned*)(C.lds + MISC_OFF);
    if (C.tid < 64) MISC[C.tid] = 0u;
    __syncthreads();
    const int lo = args.ph_lo, hi = args.ph_hi;
    const bool multi = (hi - lo) > 1;
    XcdBarrier bar; bar.bar = (unsigned*)(ctl + CW_BAR); bar.x = 0; bar.st = nullptr;
    if (multi) bar = xcd_barrier_post((unsigned*)(ctl + CW_BAR), MISC);

    if (IN(0)) init_phase(C, args);
    SEAM(0);
    layer_body<0>(C, args, lo, hi, bar, ctl);
    layer_body<1>(C, args, lo, hi, bar, ctl);
}
#undef IN
#undef SEAM

#ifndef MK_MULTI_LAUNCH
#define MK_MULTI_LAUNCH 0
#endif
#ifndef PROBE_REP_MASK
#define PROBE_REP_MASK 0u
#endif
#ifndef PROBE_SUB
#define PROBE_SUB SUB_ALL
#endif
extern "C" void kernel_launch(void* const* d_in, const int* in_sizes, int n_in, void* d_out, int out_size, void* d_ws, size_t ws_size, hipStream_t stream) {
    static int grid = 0;
    if (grid == 0) {
        if (n_in != 18 || out_size != M * D || ws_size < WS_END) { fprintf(stderr, "kernel_launch: unexpected shapes: n_in %d out %d ws %zu (need %zu)\n", n_in, out_size, ws_size, (size_t)WS_END); grid = -1; return; }
        int dev = 0, cus = 0, per_cu = 0;
        if (hipGetDevice(&dev) != hipSuccess || hipDeviceGetAttribute(&cus, hipDeviceAttributeMultiprocessorCount, dev) != hipSuccess) { grid = -1; return; }
        if (hipFuncSetAttribute((const void*)mk_fwd, hipFuncAttributeMaxDynamicSharedMemorySize, LDS_BYTES) != hipSuccess) { fprintf(stderr, "kernel_launch: hipFuncSetAttribute failed\n"); grid = -1; return; }
        if (hipOccupancyMaxActiveBlocksPerMultiprocessor(&per_cu, (const void*)mk_fwd, NTHREADS, LDS_BYTES) != hipSuccess || per_cu < 1) fprintf(stderr, "kernel_launch: occupancy query says %d\n", per_cu);
        (void)hipGetLastError();
        grid = cus;
    }
    if (grid < 0) return;
    (void)hipMemsetAsync((char*)d_ws + WS_CTL, 0, CTL_ZERO_BYTES, stream);
    Args a{};
    for (int i = 0; i < 18; ++i) a.in[i] = (const float*)d_in[i];
    a.out = (float*)d_out; a.ws = (unsigned char*)d_ws;
#if MK_MULTI_LAUNCH
    for (int ph = 0; ph < N_PHASES; ++ph) { a.ph_lo = ph; a.ph_hi = ph + 1;
        for (int rep = 0; rep < 1 + (int)((PROBE_REP_MASK >> ph) & 1u); ++rep) { a.sub = rep ? (PROBE_SUB) : SUB_ALL; a.qrep = rep; hipLaunchKernelGGL(mk_fwd, dim3(grid), dim3(NTHREADS), LDS_BYTES, stream, a); } }
#else
    a.ph_lo = 0; a.ph_hi = N_PHASES; a.sub = SUB_ALL; a.qrep = 0; hipLaunchKernelGGL(mk_fwd, dim3(grid), dim3(NTHREADS), LDS_BYTES, stream, a);
#endif
}
```
